# Optimizing an MI355X kernel written in HIP

```python
import math
import jax, jax.numpy as jnp
from jax import lax
import numpy as np

D_MODEL = 1024
BATCH = 4
SEQ = 4096
DEPTH = 1
DEC_BATCH = 8
DEC_SEQ = 16
PAST_LEN = 2048

CHUNK = 64
Q_BLOCK = 128
N_HEADS = 8
QK_NOPE = 64
ROPE_DIM = 32
V_DIM = 64
Q_LORA = 384
KV_LORA = 256
QK_DIM = QK_NOPE + ROPE_DIM
MLA_WIDTH = N_HEADS * V_DIM
S5_GROUP_SIZE = 16
S5_WIDTH = 512
S5_GROUPS = S5_WIDTH // S5_GROUP_SIZE
S5_STATE = 64
D_MIX = MLA_WIDTH + S5_WIDTH
D_IN = Q_LORA + KV_LORA + ROPE_DIM + S5_WIDTH
D_FF = 2816
CONV_W = 3
ROPE_THETA = 10000.0
EPS = 1e-6
ATTN_SCALE = 1.0 / math.sqrt(QK_DIM)
NEG_INF = -1e30

kernel_name = "hybrid_mla_s5_convffn_stream_step"


def _rmsnorm(x, g):
    xf = x.astype(jnp.float32)
    xf = xf * lax.rsqrt(jnp.mean(xf * xf, axis=-1, keepdims=True) + EPS)
    return (xf * g.astype(jnp.float32)).astype(x.dtype)


def _rope_tables(pos):
    inv_freq = ROPE_THETA ** (-jnp.arange(0, ROPE_DIM, 2, dtype=jnp.float32) / ROPE_DIM)
    ang = pos.astype(jnp.float32)[:, None] * inv_freq[None, :]
    return jnp.cos(ang), jnp.sin(ang)


def _rope(x, cos, sin):
    half = ROPE_DIM // 2
    x1 = x[..., :half].astype(jnp.float32)
    x2 = x[..., half:].astype(jnp.float32)
    out = jnp.concatenate([x1 * cos - x2 * sin, x2 * cos + x1 * sin], axis=-1)
    return out.astype(x.dtype)


def _mla_keys(c_kv, k_pe, p):
    B, T, _ = c_kv.shape
    kv = (c_kv @ p["w_kv_b"]).reshape(B, T, N_HEADS, QK_NOPE + V_DIM)
    k_nope, v = kv[..., :QK_NOPE], kv[..., QK_NOPE:]
    k_rot = jnp.broadcast_to(k_pe[:, :, None, :], (B, T, N_HEADS, ROPE_DIM))
    k = _rmsnorm(jnp.concatenate([k_nope, k_rot], axis=-1), p["g_k_head"])
    return k, v


def _attn_prompt(q, k, v):
    B, S, H, Dq = q.shape
    nb = S // Q_BLOCK
    qb = q.reshape(B, nb, Q_BLOCK, H, Dq).transpose(1, 0, 2, 3, 4)
    key_chunk = jnp.arange(S) // CHUNK

    def one(args):
        qi, i = args
        q_chunk = (i * Q_BLOCK + jnp.arange(Q_BLOCK)) // CHUNK
        s = jnp.einsum('bqhd,bkhd->bhqk', qi, k).astype(jnp.float32) * ATTN_SCALE
        mask = key_chunk[None, :] <= q_chunk[:, None]
        s = jnp.where(mask[None, None], s, NEG_INF)
        pr = jax.nn.softmax(s, axis=-1).astype(v.dtype)
        return jnp.einsum('bhqk,bkhd->bqhd', pr, v)

    o = lax.map(one, (qb, jnp.arange(nb)))
    return o.transpose(1, 0, 2, 3, 4).reshape(B, S, H * V_DIM)


def _attn_sample(q, k, v):
    B, S, H, _ = q.shape
    s = jnp.einsum('bqhd,bkhd->bhqk', q, k).astype(jnp.float32) * ATTN_SCALE
    pr = jax.nn.softmax(s, axis=-1).astype(v.dtype)
    return jnp.einsum('bhqk,bkhd->bqhd', pr, v).reshape(B, S, H * V_DIM)


def _s5(u, h0_re, h0_im, p):
    B, S, _ = u.shape
    ug = u.reshape(B, S, S5_GROUPS, S5_GROUP_SIZE)
    a_re, a_im = p["s5_a_re"], p["s5_a_im"]
    dt = jnp.exp(p["s5_log_dt"])[:, None]
    mag = jnp.exp(a_re * dt)
    ang = a_im * dt
    lb_re, lb_im = mag * jnp.cos(ang), mag * jnp.sin(ang)
    nr, ni = lb_re - 1.0, lb_im
    den = a_re * a_re + a_im * a_im
    f_re = (nr * a_re + ni * a_im) / den
    f_im = (ni * a_re - nr * a_im) / den
    b_re, b_im = p["s5_b_re"], p["s5_b_im"]
    bb_re = f_re[..., None] * b_re - f_im[..., None] * b_im
    bb_im = f_re[..., None] * b_im + f_im[..., None] * b_re
    bu_re = jnp.einsum('gpc,bsgc->bsgp', bb_re, ug)
    bu_im = jnp.einsum('gpc,bsgc->bsgp', bb_im, ug)
    la_re = jnp.broadcast_to(lb_re, bu_re.shape)
    la_im = jnp.broadcast_to(lb_im, bu_re.shape)

    def comb(e1, e2):
        a1r, a1i, b1r, b1i = e1
        a2r, a2i, b2r, b2i = e2
        return (a2r * a1r - a2i * a1i,
                a2r * a1i + a2i * a1r,
                a2r * b1r - a2i * b1i + b2r,
                a2r * b1i + a2i * b1r + b2i)

    ar, ai, sr, si = lax.associative_scan(comb, (la_re, la_im, bu_re, bu_im), axis=1)
    if h0_re is not None:
        h_re, h_im = h0_re[:, None], h0_im[:, None]
        sr, si = sr + ar * h_re - ai * h_im, si + ar * h_im + ai * h_re
    y = (jnp.einsum('gcp,bsgp->bsgc', p["s5_c_re"], sr)
         - jnp.einsum('gcp,bsgp->bsgc', p["s5_c_im"], si))
    y = y.reshape(B, S, S5_WIDTH) + p["s5_d"] * u
    g = jax.nn.gelu(y)
    out = g * jax.nn.sigmoid(g @ p["w_s5_glu"] + p["b_s5_glu"])
    return out, sr[:, -1], si[:, -1]


def _conv_ffn(xn, conv_hist, p):
    up = xn @ p["w_up"]
    B, S, C = up.shape
    if conv_hist is None:
        conv_hist = jnp.zeros((B, CONV_W - 1, C), up.dtype)
    full = jnp.concatenate([conv_hist.astype(up.dtype), up], axis=1)
    w = p["w_dw"]
    conv = w[0] * full[:, 0:S] + w[1] * full[:, 1:S + 1] + w[2] * full[:, 2:S + 2] + p["b_dw"]
    gate, val = conv[..., :D_FF], conv[..., D_FF:]
    y = (jax.nn.silu(gate) * val) @ p["w_down"]
    return y, full[:, -(CONV_W - 1):]


def _block(x, past_c_kv, past_k_pe, h0_re, h0_im, conv_hist, p):
    B, S, _ = x.shape
    past = 0 if past_c_kv is None else past_c_kv.shape[1]
    pos = past + jnp.arange(S)
    cos, sin = _rope_tables(pos)
    xn = _rmsnorm(x, p["g_mix_norm"])
    hin = xn @ p["w_in"]
    q_lat = hin[..., :Q_LORA]
    kv_lat = hin[..., Q_LORA:Q_LORA + KV_LORA]
    k_pe = hin[..., Q_LORA + KV_LORA:Q_LORA + KV_LORA + ROPE_DIM]
    u = hin[..., Q_LORA + KV_LORA + ROPE_DIM:]
    c_q = _rmsnorm(q_lat, p["g_q_a"])
    q = (c_q @ p["w_q_b"]).reshape(B, S, N_HEADS, QK_DIM)
    q = jnp.concatenate([q[..., :QK_NOPE], _rope(q[..., QK_NOPE:], cos[:, None], sin[:, None])], axis=-1)
    q = _rmsnorm(q, p["g_q_head"])
    c_kv = _rmsnorm(kv_lat, p["g_kv_a"])
    k_pe = _rope(k_pe, cos, sin)
    if past_c_kv is None:
        k, v = _mla_keys(c_kv, k_pe, p)
        o_a = _attn_prompt(q, k, v)
    else:
        k, v = _mla_keys(jnp.concatenate([past_c_kv.astype(c_kv.dtype), c_kv], axis=1),
                         jnp.concatenate([past_k_pe.astype(k_pe.dtype), k_pe], axis=1), p)
        o_a = _attn_sample(q, k, v)
    o_b, s_re, s_im = _s5(u, h0_re, h0_im, p)
    h = x + jnp.concatenate([o_a, o_b], axis=-1) @ p["w_out"]
    f, conv_state = _conv_ffn(_rmsnorm(h, p["g_ffn_norm"]), conv_hist, p)
    return h + f, c_kv, k_pe, s_re, s_im, conv_state


def setup_inputs(seed: int = 0) -> dict:
    key = jax.random.key(seed)
    ks = iter(jax.random.split(key, 40))
    nrm = lambda shape, s: jax.random.normal(next(ks), shape, jnp.float32) * s
    L = DEPTH
    n_idx = jnp.arange(S5_STATE, dtype=jnp.float32)
    return {
        "x_prompt": nrm((BATCH, SEQ, D_MODEL), 1.0),
        "x_sample": nrm((DEC_BATCH, DEC_SEQ, D_MODEL), 1.0),
        "cache_kv_latent": nrm((L, DEC_BATCH, PAST_LEN, KV_LORA), 1.0),
        "cache_k_rope": nrm((L, DEC_BATCH, PAST_LEN, ROPE_DIM), 1.0),
        "state_s5_re": nrm((L, DEC_BATCH, S5_GROUPS, S5_STATE), 0.5),
        "state_s5_im": nrm((L, DEC_BATCH, S5_GROUPS, S5_STATE), 0.5),
        "state_ffn_conv": nrm((L, DEC_BATCH, CONV_W - 1, 2 * D_FF), 0.5),
        "g_mix_norm": 1.0 + nrm((L, D_MODEL), 0.02),
        "w_in": nrm((L, D_MODEL, D_IN), D_MODEL ** -0.5),
        "g_q_a": 1.0 + nrm((L, Q_LORA), 0.02),
        "w_q_b": nrm((L, Q_LORA, N_HEADS * QK_DIM), Q_LORA ** -0.5),
        "g_kv_a": 1.0 + nrm((L, KV_LORA), 0.02),
        "w_kv_b": nrm((L, KV_LORA, N_HEADS * (QK_NOPE + V_DIM)), KV_LORA ** -0.5),
        "g_q_head": 1.0 + nrm((L, QK_DIM), 0.02),
        "g_k_head": 1.0 + nrm((L, QK_DIM), 0.02),
        "s5_a_re": -0.5 + nrm((L, S5_GROUPS, S5_STATE), 0.01),
        "s5_a_im": math.pi * n_idx + nrm((L, S5_GROUPS, S5_STATE), 0.01),
        "s5_log_dt": jax.random.uniform(next(ks), (L, S5_GROUPS), jnp.float32, math.log(1e-3), math.log(1e-1)),
        "s5_b_re": nrm((L, S5_GROUPS, S5_STATE, S5_GROUP_SIZE), (2 * S5_GROUP_SIZE) ** -0.5),
        "s5_b_im": nrm((L, S5_GROUPS, S5_STATE, S5_GROUP_SIZE), (2 * S5_GROUP_SIZE) ** -0.5),
        "s5_c_re": nrm((L, S5_GROUPS, S5_GROUP_SIZE, S5_STATE), (2 * S5_STATE) ** -0.5),
        "s5_c_im": nrm((L, S5_GROUPS, S5_GROUP_SIZE, S5_STATE), (2 * S5_STATE) ** -0.5),
        "s5_d": nrm((L, S5_WIDTH), 1.0),
        "w_s5_glu": nrm((L, S5_WIDTH, S5_WIDTH), S5_WIDTH ** -0.5),
        "b_s5_glu": nrm((L, S5_WIDTH), 0.01),
        "w_out": nrm((L, D_MIX, D_MODEL), D_MIX ** -0.5),
        "g_ffn_norm": 1.0 + nrm((L, D_MODEL), 0.02),
        "w_up": nrm((L, D_MODEL, 2 * D_FF), D_MODEL ** -0.5),
        "w_dw": nrm((L, CONV_W, 2 * D_FF), CONV_W ** -0.5),
        "b_dw": nrm((L, 2 * D_FF), 0.01),
        "w_down": nrm((L, D_FF, D_MODEL), D_FF ** -0.5),
    }


def reference(x_prompt, x_sample, cache_kv_latent, cache_k_rope, state_s5_re, state_s5_im, state_ffn_conv,
              g_mix_norm, w_in, g_q_a, w_q_b, g_kv_a, w_kv_b, g_q_head, g_k_head,
              s5_a_re, s5_a_im, s5_log_dt, s5_b_re, s5_b_im, s5_c_re, s5_c_im, s5_d, w_s5_glu, b_s5_glu,
              w_out, g_ffn_norm, w_up, w_dw, b_dw, w_down):
    yp, ys = x_prompt, x_sample
    per_p, per_s = [], []
    for l in range(DEPTH):
        p = dict(g_mix_norm=g_mix_norm[l], w_in=w_in[l], g_q_a=g_q_a[l], w_q_b=w_q_b[l],
                 g_kv_a=g_kv_a[l], w_kv_b=w_kv_b[l], g_q_head=g_q_head[l], g_k_head=g_k_head[l],
                 s5_a_re=s5_a_re[l], s5_a_im=s5_a_im[l], s5_log_dt=s5_log_dt[l],
                 s5_b_re=s5_b_re[l], s5_b_im=s5_b_im[l], s5_c_re=s5_c_re[l], s5_c_im=s5_c_im[l],
                 s5_d=s5_d[l], w_s5_glu=w_s5_glu[l], b_s5_glu=b_s5_glu[l], w_out=w_out[l],
                 g_ffn_norm=g_ffn_norm[l], w_up=w_up[l], w_dw=w_dw[l], b_dw=b_dw[l], w_down=w_down[l])
        yp, ckv_p, kpe_p, sre_p, sim_p, conv_p = _block(yp, None, None, None, None, None, p)
        ys, ckv_s, kpe_s, sre_s, sim_s, conv_s = _block(
            ys, cache_kv_latent[l], cache_k_rope[l], state_s5_re[l], state_s5_im[l], state_ffn_conv[l], p)
        per_p.append((ckv_p, kpe_p, sre_p, sim_p, conv_p))
        per_s.append((ckv_s, kpe_s, sre_s, sim_s, conv_s))
    np_ = [jnp.stack(t, axis=0) for t in zip(*per_p)]
    ns_ = [jnp.stack(t, axis=0) for t in zip(*per_s)]
    return (yp, ys, np_[0], np_[1], np_[2], np_[3], np_[4], ns_[0], ns_[1], ns_[2], ns_[3], ns_[4])
```

```cpp
#include <hip/hip_runtime.h>
#include <hip/hip_cooperative_groups.h>
#include <cstdio>
#include <cstdint>
namespace cg = cooperative_groups;
__device__ __forceinline__ int lane_id_asm() { int l; asm volatile("v_mbcnt_lo_u32_b32 %0, -1, 0\n\tv_mbcnt_hi_u32_b32 %0, -1, %0" : "=v"(l)); return l; }
namespace pg8 {
#define PG8_LAS __attribute__((address_space(3)))
typedef unsigned short bf16_t;
typedef short bf16x8 __attribute__((ext_vector_type(8)));
typedef float f32x4 __attribute__((ext_vector_type(4)));
typedef unsigned u32x4 __attribute__((ext_vector_type(4)));
constexpr int BM = 256, BK = 64, HALF = 128, HTB = HALF * BK * 2  , STAGE_BYTES = 8 * HTB, NXCD = 8, WGM = 8;

__host__ __device__ __forceinline__ int lds_byte(int r, int c) { const int st = (r >> 4) * 2 + (c >> 5), rr = r & 15, cc = c & 31, ob = rr * 64 + cc * 2; return st * 1024 + (ob ^ (((ob >> 9) & 1) << 5)); }
__host__ __device__ __forceinline__ void stage_rc(int b, int& R, int& C) { const int st = b / 1024, sb = b % 1024, swz = sb ^ (((sb >> 9) & 1) << 5); R = (st >> 1) * 16 + swz / 64; C = (st & 1) * 32 + (swz % 64) / 2; }
__host__ __device__ __forceinline__ int perm32(int rho) { const int n = rho >> 4, i = rho & 15; return 8 * (i >> 2) + 4 * n + (i & 3); }

struct Unit { int pm, pn; };
struct Gemm { const bf16_t* A; const bf16_t* Bt; int M, N, K; };

struct StaticOrder {
    int nM, nN, nwg, G, c, wave_s;
    __host__ __device__ void init(int M, int N, int G_, int c_) { nM = M / BM; nN = N / BM; nwg = nM * nN; G = G_; c = c_; }
    __host__ __device__ bool next(int i, Unit& u) const {
        const long L = (long)i * G + c; if (L >= nwg) return false;
        int wgid = (int)L; { const int q = nwg / NXCD, r = nwg % NXCD, xcd = wgid % NXCD, off = wgid / NXCD; wgid = (xcd < r ? xcd * (q + 1) : r * (q + 1) + (xcd - r) * q) + off; }
        const int nig = WGM * nN, gid = wgid / nig, fm = gid * WGM, gsz = (nM - fm) < WGM ? (nM - fm) : WGM;
        u.pm = fm + ((wgid % nig) % gsz); u.pn = (wgid % nig) / gsz; return true;
    }
    __device__ __forceinline__ void a_ready(const Unit&) const {}
    __device__ __forceinline__ void done(const Unit&) const {}
};

__device__ __forceinline__ unsigned cvt_pk_bf16(float lo, float hi) { unsigned r; asm volatile("v_cvt_pk_bf16_f32 %0, %1, %2" : "=v"(r) : "v"(lo), "v"(hi)); return r; }
typedef float f32x2 __attribute__((ext_vector_type(2)));
__device__ __forceinline__ f32x2 gelu_pk(f32x2 v) {
    const f32x2 av = __builtin_elementwise_abs(v), d = av * 0.2316418882f + 1.0f;
    f32x2 t; t.x = __builtin_amdgcn_rcpf(d.x); t.y = __builtin_amdgcn_rcpf(d.y);
    f32x2 q = t * 0.5307027145f + (-0.7265760135f); q = q * t + 0.7107068705f; q = q * t + (-0.142248368f); q = q * t + 0.127414796f; q = q * t;
    const f32x2 s = (v * v) * (-0.72134752044f);
    f32x2 e; e.x = __builtin_amdgcn_exp2f(s.x); e.y = __builtin_amdgcn_exp2f(s.y);
    const f32x2 m = v * (q * e), r = v - m;
    f32x2 o; o.x = v.x < 0.f ? m.x : r.x; o.y = v.y < 0.f ? m.y : r.y; return o;
}

template <int ACT  > struct EpiBf16 {
    static constexpr bool PERM = true, AFTER_DRAIN = false; static_assert(ACT == 0 || ACT == 1, "EpiBf16: ACT is 0 (none) or 1 (gelu_pk)");
    bf16_t* O; int ldc; const float* bias; int split_cols; size_t split_stride; float scale0;
    __device__ __forceinline__ void operator()(const f32x4 (&acc)[2][2][4][2], const Unit& u, int wr, int wc, int fr, int fq) const {
        const int row0 = u.pm * BM + wr * 64 + fr; int colt = u.pn * BM; bf16_t* base = O;
        float sc = 1.f; if (split_cols) { const int t = colt / split_cols; base += (size_t)t * split_stride; colt -= t * split_cols; if (t == 0) sc = scale0; }
        const int col0 = colt + wc * 32 + 8 * fq, bcol0 = u.pn * BM + wc * 32 + 8 * fq;
        f32x4 bv[2][2];
#pragma unroll
        for (int bj = 0; bj < 2; ++bj)
#pragma unroll
            for (int n = 0; n < 2; ++n) bv[bj][n] = bias ? *(const f32x4*)(bias + bcol0 + bj * HALF + 4 * n) : (f32x4){0.f, 0.f, 0.f, 0.f};
#pragma unroll
        for (int ai = 0; ai < 2; ++ai)
#pragma unroll
            for (int m = 0; m < 4; ++m) { bf16_t* rowp = base + (size_t)(row0 + ai * HALF + m * 16) * ldc + col0;
#pragma unroll
                for (int bj = 0; bj < 2; ++bj) { f32x4 v0 = acc[ai][bj][m][0] + bv[bj][0], v1 = acc[ai][bj][m][1] + bv[bj][1];
                    if (ACT == 1) { f32x2 a = gelu_pk((f32x2){v0[0], v0[1]}), b = gelu_pk((f32x2){v0[2], v0[3]}), c = gelu_pk((f32x2){v1[0], v1[1]}), d = gelu_pk((f32x2){v1[2], v1[3]});
                        v0 = (f32x4){a.x, a.y, b.x, b.y}; v1 = (f32x4){c.x, c.y, d.x, d.y}; }
                    v0 = v0 * sc; v1 = v1 * sc; u32x4 w; w.x = cvt_pk_bf16(v0[0], v0[1]); w.y = cvt_pk_bf16(v0[2], v0[3]); w.z = cvt_pk_bf16(v1[0], v1[1]); w.w = cvt_pk_bf16(v1[2], v1[3]);
                    *(u32x4*)(rowp + bj * HALF) = w; } }
    }
};
template <class Epi, class Sched, bool ALIGN_EPI = false, bool SP2 = false>
__device__ __forceinline__ void gemm_phase(PG8_LAS unsigned char* lds, const Gemm g, const Sched& S, const Epi& E) {
    int tid_ = lane_id_asm() + 64 * S.wave_s; asm volatile("" : "+v"(tid_));
    const int tid = tid_, wid = __builtin_amdgcn_readfirstlane(tid >> 6), lane = tid & 63, wr = wid >> 2, wc = wid & 3, fr = lane & 15, fq = lane >> 4;
    const int K = g.K, nt = K / BK;
    unsigned voffA[2], voffB[2];
#pragma unroll
    for (int i = 0; i < 2; ++i) { int R, C; stage_rc(tid * 16 + i * 8192, R, C); const int Rb = Epi::PERM ? ((R & ~31) + perm32(R & 31)) : R;
        voffA[i] = (unsigned)(R * K + C) * 2u; voffB[i] = (unsigned)(Rb * K + C) * 2u; }
    const size_t kstep = (size_t)(BK * 2);
    const size_t hstep = (size_t)HALF * K * 2;
    const size_t tstep = 2 * hstep;
    const unsigned ldsw = (unsigned)wid * 1024u;
    const int aoff = lds_byte(wr * 64 + fr, fq * 8), boff = lds_byte(wc * 32 + fr, fq * 8);
#define PG8_SA(b, h) (((b) * 2 + (h)) * HTB)
#define PG8_SB(b, h) ((4 + (b) * 2 + (h)) * HTB)
#define PG8_STAGE(bufoff, gbase, voff) do { _Pragma("unroll") for (int _i = 0; _i < 2; ++_i) \
        __builtin_amdgcn_global_load_lds((const unsigned*)((const char*)(gbase) + (voff)[_i]), (PG8_LAS unsigned*)(lds + (bufoff) + ldsw + _i * 8192), 16, 0, 0); } while (0)
#define PG8_LDA(dst, b, h) do { _Pragma("unroll") for (int m = 0; m < 4; ++m) _Pragma("unroll") for (int k = 0; k < 2; ++k) dst[m][k] = *(const PG8_LAS bf16x8*)(lds + PG8_SA(b, h) + aoff + m * 2048 + k * 1024); } while (0)
#define PG8_LDB(dst, b, h) do { _Pragma("unroll") for (int n = 0; n < 2; ++n) _Pragma("unroll") for (int k = 0; k < 2; ++k) dst[n][k] = *(const PG8_LAS bf16x8*)(lds + PG8_SB(b, h) + boff + n * 2048 + k * 1024); } while (0)
#define PG8_MMA(ai, bj, At, Bt) do { __builtin_amdgcn_s_setprio(1); _Pragma("unroll") for (int m = 0; m < 4; ++m) _Pragma("unroll") for (int n = 0; n < 2; ++n) _Pragma("unroll") for (int k = 0; k < 2; ++k) \
        acc[ai][bj][m][n] = __builtin_amdgcn_mfma_f32_16x16x32_bf16(Bt[n][k], At[m][k], acc[ai][bj][m][n], 0, 0, 0); __builtin_amdgcn_s_setprio(0); } while (0)
#define PG8_WAIT_V(n) asm volatile("s_waitcnt vmcnt(" #n ")" ::: "memory")
#define PG8_WAIT_L(n) asm volatile("s_waitcnt lgkmcnt(" #n ")" ::: "memory")
#define PG8_BAR __builtin_amdgcn_s_barrier()
#define PG8_SCHED __builtin_amdgcn_sched_barrier(0)
    Unit cur, nxt; int ui = 0;
    if (!S.next(0, cur)) return;
    f32x4 acc[2][2][4][2];
#pragma unroll
    for (int a = 0; a < 2; ++a)
#pragma unroll
        for (int b = 0; b < 2; ++b)
#pragma unroll
            for (int m = 0; m < 4; ++m)
#pragma unroll
                for (int n = 0; n < 2; ++n) acc[a][b][m][n] = (f32x4){0.f, 0.f, 0.f, 0.f};
    bf16x8 At[4][2], B0[2][2], B1[2][2];
    const char* cA = (const char*)g.A + (size_t)cur.pm * tstep; const char* cB = (const char*)g.Bt + (size_t)cur.pn * tstep;
    S.a_ready(cur);
    if constexpr (SP2) {
        PG8_STAGE(PG8_SB(0, 0), cB, voffB); PG8_STAGE(PG8_SB(0, 1), cB + hstep, voffB); PG8_STAGE(PG8_SA(0, 0), cA, voffA); PG8_STAGE(PG8_SA(0, 1), cA + hstep, voffA);
        if (wr == 1) PG8_BAR;
        PG8_WAIT_V(2); PG8_BAR;
        PG8_STAGE(PG8_SB(1, 0), cB + kstep, voffB); PG8_STAGE(PG8_SA(1, 0), cA + kstep, voffA); PG8_STAGE(PG8_SB(1, 1), cB + hstep + kstep, voffB);
        PG8_WAIT_V(6); PG8_BAR;
    } else {
        PG8_STAGE(PG8_SB(0, 0), cB, voffB); PG8_STAGE(PG8_SA(0, 0), cA, voffA); PG8_STAGE(PG8_SB(0, 1), cB + hstep, voffB); PG8_STAGE(PG8_SA(0, 1), cA + hstep, voffA);
        if (wr == 1) PG8_BAR;
        PG8_WAIT_V(4); PG8_BAR;
        PG8_STAGE(PG8_SB(1, 0), cB + kstep, voffB); PG8_STAGE(PG8_SA(1, 0), cA + kstep, voffA); PG8_STAGE(PG8_SB(1, 1), cB + hstep + kstep, voffB);
        PG8_WAIT_V(6); PG8_BAR;
    }
    for (;;) {
        const bool has_next = S.next(ui + 1, nxt);
        const char* nA = has_next ? (const char*)g.A + (size_t)nxt.pm * tstep : cA; const char* nB = has_next ? (const char*)g.Bt + (size_t)nxt.pn * tstep : cB;
        for (int t = 0; t < nt; t += 2) {
            const bool last = (t == nt - 2);
            const char* a1 = cA + (size_t)(t + 1) * kstep;
            const char* a2 = last ? nA : cA + (size_t)(t + 2) * kstep; const char* b2 = last ? nB : cB + (size_t)(t + 2) * kstep;
            const char* a3 = a2 + kstep; const char* b3 = b2 + kstep;
            if (last && has_next) S.a_ready(nxt);
            if constexpr (SP2) {
            PG8_LDB(B0, 0, 0); PG8_LDB(B1, 0, 1); PG8_SCHED; PG8_LDA(At, 0, 0); PG8_STAGE(PG8_SA(1, 1), a1 + hstep, voffA);
            PG8_WAIT_V(8); PG8_WAIT_L(0); PG8_BAR; PG8_MMA(0, 0, At, B0); PG8_MMA(0, 1, At, B1); PG8_BAR; PG8_SCHED;
            PG8_LDA(At, 0, 1); PG8_STAGE(PG8_SB(0, 0), b2, voffB); PG8_STAGE(PG8_SB(0, 1), b2 + hstep, voffB); PG8_STAGE(PG8_SA(0, 0), a2, voffA);
            PG8_WAIT_V(8); PG8_WAIT_L(0); PG8_BAR; PG8_MMA(1, 0, At, B0); PG8_MMA(1, 1, At, B1); PG8_BAR; PG8_SCHED;
            PG8_LDB(B0, 1, 0); PG8_LDB(B1, 1, 1); PG8_SCHED; PG8_LDA(At, 1, 0); PG8_STAGE(PG8_SA(0, 1), a2 + hstep, voffA);
            PG8_WAIT_V(8); PG8_WAIT_L(0); PG8_BAR; PG8_MMA(0, 0, At, B0); PG8_MMA(0, 1, At, B1); PG8_BAR; PG8_SCHED;
            PG8_LDA(At, 1, 1); PG8_STAGE(PG8_SB(1, 0), b3, voffB); PG8_STAGE(PG8_SB(1, 1), b3 + hstep, voffB); PG8_STAGE(PG8_SA(1, 0), a3, voffA);
            PG8_WAIT_V(8); PG8_WAIT_L(0); PG8_BAR; PG8_MMA(1, 0, At, B0); PG8_MMA(1, 1, At, B1); PG8_BAR; PG8_SCHED;
            } else {
            PG8_LDB(B0, 0, 0); PG8_SCHED; PG8_LDA(At, 0, 0); PG8_STAGE(PG8_SA(1, 1), a1 + hstep, voffA);
            PG8_WAIT_L(8); PG8_BAR; PG8_WAIT_L(0); PG8_MMA(0, 0, At, B0); PG8_BAR; PG8_SCHED;
            PG8_LDB(B1, 0, 1); PG8_STAGE(PG8_SB(0, 0), b2, voffB);
            PG8_BAR; PG8_WAIT_L(0); PG8_MMA(0, 1, At, B1); PG8_BAR;
            PG8_LDA(At, 0, 1); PG8_STAGE(PG8_SA(0, 0), a2, voffA);
            PG8_BAR; PG8_WAIT_L(0); PG8_MMA(1, 0, At, B0); PG8_BAR; PG8_SCHED;
            PG8_STAGE(PG8_SB(0, 1), b2 + hstep, voffB);
            PG8_WAIT_V(6); PG8_BAR; PG8_MMA(1, 1, At, B1); PG8_BAR;
            PG8_LDB(B0, 1, 0); PG8_SCHED; PG8_LDA(At, 1, 0); PG8_STAGE(PG8_SA(0, 1), a2 + hstep, voffA);
            PG8_WAIT_L(8); PG8_BAR; PG8_WAIT_L(0); PG8_MMA(0, 0, At, B0); PG8_BAR; PG8_SCHED;
            PG8_LDB(B1, 1, 1); PG8_STAGE(PG8_SB(1, 0), b3, voffB);
            PG8_BAR; PG8_WAIT_L(0); PG8_MMA(0, 1, At, B1); PG8_BAR;
            PG8_LDA(At, 1, 1); PG8_STAGE(PG8_SA(1, 0), a3, voffA);
            PG8_BAR; PG8_WAIT_L(0); PG8_MMA(1, 0, At, B0); PG8_BAR; PG8_SCHED;
            PG8_STAGE(PG8_SB(1, 1), b3 + hstep, voffB);
            PG8_WAIT_V(6); PG8_BAR; PG8_MMA(1, 1, At, B1); PG8_BAR;
            }
        }
        if constexpr (ALIGN_EPI) { if (wr == 0) PG8_BAR; }
        if constexpr (!Epi::AFTER_DRAIN) { int fr_ = fr, fq_ = fq; asm volatile("" : "+v"(fr_), "+v"(fq_)); E(acc, cur, wr, wc, fr_, fq_); S.done(cur); }
        if (!has_next) break;
#pragma unroll
        for (int a = 0; a < 2; ++a)
#pragma unroll
            for (int b = 0; b < 2; ++b)
#pragma unroll
                for (int m = 0; m < 4; ++m)
#pragma unroll
                    for (int n = 0; n < 2; ++n) acc[a][b][m][n] = (f32x4){0.f, 0.f, 0.f, 0.f};
        cur = nxt; cA = nA; cB = nB; ++ui;
        if constexpr (ALIGN_EPI) { if (wr == 1) PG8_BAR; }
    }
    PG8_WAIT_V(0);
    if constexpr (!ALIGN_EPI) { if (wr == 0) PG8_BAR; }
    PG8_BAR;
    if constexpr (Epi::AFTER_DRAIN) { E.fused(acc, cur, wr, wc, fr, fq, lds, wid, lane); S.done(cur); }
#undef PG8_SA
#undef PG8_SB
#undef PG8_STAGE
#undef PG8_LDA
#undef PG8_LDB
#undef PG8_MMA
#undef PG8_WAIT_V
#undef PG8_WAIT_L
#undef PG8_BAR
#undef PG8_SCHED
}
}
#define LAS __attribute__((address_space(3)))
typedef unsigned short bf16_t;
typedef short bf16x8 __attribute__((ext_vector_type(8)));
typedef short s16x4 __attribute__((ext_vector_type(4)));
typedef float f32x4 __attribute__((ext_vector_type(4)));
typedef float f32x16 __attribute__((ext_vector_type(16)));
typedef unsigned u32x4 __attribute__((ext_vector_type(4)));
typedef unsigned u32x2 __attribute__((ext_vector_type(2)));

constexpr int MPR = 16384, MV = 16512, MP = 16640, MKV = 33280, SKVB = 2112, NIN = 1280;
constexpr float EPSF = 1e-6f;
constexpr size_t KiB = 1024;
constexpr size_t WS_CTL = 0, WS_WIN = 1024 * KiB, WS_WQ = 3584 * KiB, WS_WKV = 4352 * KiB, WS_WGLU = 4864 * KiB, WS_WOUT = 5376 * KiB, WS_WUP = 7424 * KiB, WS_WDN = 18688 * KiB;
constexpr size_t WS_ROPE = 24576 * KiB, WS_POW = 25088 * KiB, WS_KP = 26624 * KiB, WS_FT = 28672 * KiB, WS_ET = 36864 * KiB, WS_BB = 45056 * KiB, WS_SLOC = 46080 * KiB, WS_KROT = 50176 * KiB, WS_ROTSS = 54336 * KiB;
constexpr size_t WS_H1 = 55296 * KiB, WS_HB = WS_H1, WS_XN = 97280 * KiB, WS_QRAW = WS_XN, WS_SS = WS_XN, WS_SSS = 98432 * KiB, WS_SIDE = 98816 * KiB;
constexpr size_t WS_CQ = 131072 * KiB, WS_G = WS_CQ, WS_CKV = 143872 * KiB, WS_MIX = 160768 * KiB, WS_ACT = WS_MIX, WS_KB = 194560 * KiB, WS_END = 252288 * KiB;
constexpr size_t O_YP = 0, O_YS = 16777216, O_KVP = 16908288, O_KRP = 21102592, O_S5RP = 21626880, O_S5IP = 21635072, O_CONVP = 21643264,
                 O_KVS = 21688320, O_KRS = 21721088, O_S5RS = 21725184, O_S5IS = 21741568, O_CONVS = 21757952;
constexpr int LDS_RING = 131072, LDS_XCH = 131072, LDS_QW = 131072 + 8192, LDS_TOTAL = 147456;

struct Args { const float* in[31]; float* out; unsigned char* ws; };
typedef const __attribute__((address_space(4))) Args CArgs;
typedef CArgs& ArgsRef;

typedef float f32x2_t __attribute__((ext_vector_type(2))); typedef __bf16 bf16x2_t __attribute__((ext_vector_type(2)));
__device__ __forceinline__ unsigned pk2(float lo, float hi) { f32x2_t v = {lo, hi}; bf16x2_t b = __builtin_convertvector(v, bf16x2_t); return __builtin_bit_cast(unsigned, b); }
__device__ __forceinline__ float bflo(unsigned w) { return __uint_as_float(w << 16); }
__device__ __forceinline__ float bfhi(unsigned w) { return __uint_as_float(w & 0xffff0000u); }
__device__ __forceinline__ float wave_sum(float v) {
#pragma unroll
    for (int o = 1; o < 64; o <<= 1) v += __shfl_xor(v, o);
    return v;
}
#define LDS_WAIT() asm volatile("s_waitcnt lgkmcnt(0)" ::: "memory")
__device__ __forceinline__ float gelu_tanh(float y) {
    const float z = 0.7978845608028654f * (y + 0.044715f * y * y * y);
    const float e = __builtin_amdgcn_exp2f(2.885390081777927f * z);
    const float t = 1.f - 2.f * __builtin_amdgcn_rcpf(e + 1.f);
    return 0.5f * y * (1.f + t);
}
__device__ __forceinline__ float sigmoidf_(float z) { return __builtin_amdgcn_rcpf(1.f + __builtin_amdgcn_exp2f(-1.4426950408889634f * z)); }

__device__ __forceinline__ int rowmap(int mode, int n) {
    if (mode == 1) return n < 640 ? n : (n < 672 ? n + 512 : n - 32);
    if (mode == 2) { const int h = n >> 7, j = n & 127, isv = j >> 6, d = j & 63; return 256 * (2 * isv + (h >> 2)) + 128 * (d >> 5) + 32 * (h & 3) + (d & 31); }
    if (mode == 3) { const int isv = n >= 2816 ? 1 : 0; const int j = isv ? n - 2816 : n; return 256 * (j >> 7) + 128 * isv + (j & 127); }
    return n;
}
__device__ __forceinline__ void tr_item(const float* W, int K, int N, bf16_t* WT, LAS float* scr, int item, int lane, int mode, const float* ksc) {
    const int nblk = N / 32, kb = item / nblk, nb = item % nblk, k0 = 64 * kb, n0 = 32 * nb;
#pragma unroll 8
    for (int i = 0; i < 32; ++i) { const int kk = 2 * i + (lane >> 5); float v = W[(size_t)(k0 + kk) * N + n0 + (lane & 31)]; if (ksc) v *= ksc[k0 + kk]; scr[kk * 33 + (lane & 31)] = v; }
    LDS_WAIT();
    const int c = lane & 7;
#pragma unroll
    for (int j = 0; j < 4; ++j) { const int n = (lane >> 3) + 8 * j; const LAS float* s = scr + (8 * c) * 33 + n;
        u32x4 o; o.x = pk2(s[0 * 33], s[1 * 33]); o.y = pk2(s[2 * 33], s[3 * 33]); o.z = pk2(s[4 * 33], s[5 * 33]); o.w = pk2(s[6 * 33], s[7 * 33]);
        *(u32x4*)(WT + (size_t)rowmap(mode, n0 + n) * K + k0 + 8 * c) = o; }
    LDS_WAIT();
}
__device__ __forceinline__ void s5_lambda(ArgsRef A, int g, int p, int j, float& pr, float& pi) {
    const float dt = expf(A.in[17][g]); const float are = A.in[15][g * 64 + p], aim = A.in[16][g * 64 + p];
    const double e = (double)are * (double)dt * (double)j; double th = (double)aim * (double)dt * (double)j;
    th -= 6.283185307179586 * rint(th * 0.15915494309189535);
    const float mag = expf((float)e), r = (float)th;
    pr = mag * cosf(r); pi = mag * sinf(r);
}
__device__ __forceinline__ void p0_prologue(ArgsRef A, LAS unsigned char* lds, int tid, int lane, int wave) {
    unsigned char* ws = A.ws;
    const int G = gridDim.x, gw = blockIdx.x * 8 + wave, NGW = G * 8, gt = blockIdx.x * 512 + tid, NGT = G * 512;
    LAS float* scr = (LAS float*)(lds + wave * 16384);
    constexpr int I0 = 16 * 37, I1 = 6 * 24, I2 = 4 * 32, I3 = 8 * 16, NIT = I0 + I1 + I2 + I3;
    for (int it = gw; it < NIT; it += NGW) {
        int r = it;
        if (r < I0) { tr_item(A.in[8], 1024, 1184, (bf16_t*)(ws + WS_WIN), scr, r, lane, 1, nullptr); continue; } r -= I0;
        if (r < I1) { tr_item(A.in[10], 384, 768, (bf16_t*)(ws + WS_WQ), scr, r, lane, 0, nullptr); continue; } r -= I1;
        if (r < I2) { tr_item(A.in[12], 256, 1024, (bf16_t*)(ws + WS_WKV), scr, r, lane, 2, nullptr); continue; } r -= I2;
        tr_item(A.in[23], 512, 512, (bf16_t*)(ws + WS_WGLU), scr, r, lane, 0, nullptr);
    }
    for (int r = gw; r < 96; r += NGW) { u32x4* d = (u32x4*)((bf16_t*)(ws + WS_WIN) + (size_t)(1184 + r) * 1024); d[lane] = (u32x4){0, 0, 0, 0}; d[64 + lane] = (u32x4){0, 0, 0, 0}; }
    { const f32x4* gm = (const f32x4*)A.in[7]; bf16_t* XN = (bf16_t*)(ws + WS_XN);
      for (int r = gw; r < MV; r += 2 * NGW) {
        f32x4 v[2][4];
#pragma unroll
        for (int u = 0; u < 2; ++u) { const int rr = r + u * NGW; if (rr < MV) { const f32x4* xr = (const f32x4*)(rr < MPR ? A.in[0] + (size_t)rr * 1024 : A.in[1] + (size_t)(rr - MPR) * 1024);
#pragma unroll
            for (int j = 0; j < 4; ++j) v[u][j] = xr[lane + 64 * j]; } }
#pragma unroll
        for (int u = 0; u < 2; ++u) { const int rr = r + u * NGW; if (rr < MV) { float ss = 0.f;
#pragma unroll
            for (int j = 0; j < 4; ++j) ss += (v[u][j].x * v[u][j].x + v[u][j].y * v[u][j].y) + (v[u][j].z * v[u][j].z + v[u][j].w * v[u][j].w);
            const float rs = rsqrtf(wave_sum(ss) * (1.f / 1024.f) + EPSF);
            u32x2* o = (u32x2*)(XN + (size_t)rr * 1024);
#pragma unroll
            for (int j = 0; j < 4; ++j) { const f32x4 gg = gm[lane + 64 * j]; u32x2 w; w.x = pk2(v[u][j].x * rs * gg.x, v[u][j].y * rs * gg.y); w.y = pk2(v[u][j].z * rs * gg.z, v[u][j].w * rs * gg.w); o[lane + 64 * j] = w; } } }
      } }
    { bf16_t* CKV = (bf16_t*)(ws + WS_CKV);
      for (int i0 = gw; i0 < 16384; i0 += 4 * NGW) { f32x4 v[4];
#pragma unroll
        for (int u = 0; u < 4; ++u) { const int i = i0 + u * NGW; if (i < 16384) v[u] = ((const f32x4*)(A.in[2] + (size_t)i * 256))[lane]; }
#pragma unroll
        for (int u = 0; u < 4; ++u) { const int i = i0 + u * NGW; if (i < 16384) { const int b = i >> 11, t = i & 2047; u32x2 w; w.x = pk2(v[u].x, v[u].y); w.y = pk2(v[u].z, v[u].w); ((u32x2*)(CKV + (size_t)(16384 + b * SKVB + t) * 256))[lane] = w; } } }
      float* KROT = (float*)(ws + WS_KROT); float* ROTSS = (float*)(ws + WS_ROTSS);
      for (int i = gw; i < 8 * 48; i += NGW) { const int b = i / 48, j = i % 48; const size_t kr = (size_t)(16384 + b * SKVB + 2064 + j);
        ((u32x2*)(CKV + kr * 256))[lane] = (u32x2){0, 0}; if (lane < 32) KROT[kr * 32 + lane] = 0.f; if (lane == 0) ROTSS[kr] = 0.f; }
      for (int i = gt; i < 16384; i += NGT) { const int b = i >> 11, t = i & 2047; const size_t kr = (size_t)(16384 + b * SKVB + t); const f32x4* s = (const f32x4*)(A.in[3] + (size_t)i * 32); f32x4* d = (f32x4*)(KROT + kr * 32); float ss = 0.f;
#pragma unroll
        for (int j = 0; j < 8; ++j) { const f32x4 v = s[j]; d[j] = v; ss += (v.x * v.x + v.y * v.y) + (v.z * v.z + v.w * v.w); }
        ROTSS[kr] = ss; } }
    { float* RP = (float*)(ws + WS_ROPE);
      for (int i = gt; i < 4096 * 16; i += NGT) { const int pos = i >> 4, k = i & 15; const float inv = powf(10000.f, -(float)(2 * k) / 32.f); const float ang = (float)pos * inv;
        RP[pos * 32 + k] = cosf(ang); RP[pos * 32 + 16 + k] = sinf(ang); } }
    { float* PW = (float*)(ws + WS_POW);
      for (int i = gt; i < 32 * 65 * 64; i += NGT) { const int p = i & 63, j = (i >> 6) % 65, g = i / (65 * 64); float pr, pi; s5_lambda(A, g, p, j, pr, pi); PW[2 * i] = pr; PW[2 * i + 1] = pi; } }
    { float* BB = (float*)(ws + WS_BB);
      for (int i = gt; i < 32 * 64; i += NGT) { const int p = i & 63, g = i >> 6; float lr, li; s5_lambda(A, g, p, 1, lr, li);
        const double are = A.in[15][i], aim = A.in[16][i]; const double nr = (double)lr - 1.0, ni = li, den = are * are + aim * aim;
        const float fr = (float)((nr * are + ni * aim) / den), fi = (float)((ni * are - nr * aim) / den);
#pragma unroll
        for (int c = 0; c < 16; ++c) { const float br = A.in[18][i * 16 + c], bi = A.in[19][i * 16 + c]; BB[(i * 16 + c) * 2] = fr * br - fi * bi; BB[(i * 16 + c) * 2 + 1] = fr * bi + fi * br; } } }
}

__device__ __forceinline__ void idle_transposes(ArgsRef A, LAS unsigned char* lds, int lane, int wave, int first_block, int which) {
    unsigned char* ws = A.ws; const int gw = ((int)blockIdx.x - first_block) * 8 + wave, NGW = ((int)gridDim.x - first_block) * 8;
    LAS float* scr = (LAS float*)(lds + wave * 16384);
    constexpr int I4 = 16 * 32, I5 = 16 * 176, I6 = 44 * 32;
    if (which == 0) {
        for (int it = gw; it < I4 + I6; it += NGW) {
            if (it < I4) tr_item(A.in[25], 1024, 1024, (bf16_t*)(ws + WS_WOUT), scr, it, lane, 0, nullptr);
            else tr_item(A.in[30], 2816, 1024, (bf16_t*)(ws + WS_WDN), scr, it - I4, lane, 0, nullptr);
        }
    } else {
        for (int it = gw; it < I5; it += NGW) tr_item(A.in[27], 1024, 5632, (bf16_t*)(ws + WS_WUP), scr, it, lane, 3, A.in[26]);
    }
}
__device__ __forceinline__ void p1_tables(ArgsRef A, int tid, int first_block) {
    unsigned char* ws = A.ws; const int gt = ((int)blockIdx.x - first_block) * 512 + tid, NGT = ((int)gridDim.x - first_block) * 512;
    const float* PW = (const float*)(ws + WS_POW); const float* BB = (const float*)(ws + WS_BB); const float* Cre = A.in[20]; const float* Cim = A.in[21];
    { bf16_t* KP = (bf16_t*)(ws + WS_KP);
      for (int i = gt; i < 32 * 64 * 64; i += NGT) { const int ln = i & 63, j = (i >> 6) & 63, g = i >> 12; const int c = ln & 15, kq = ln >> 4, jj = j - (kq >> 1), c0 = 8 * (kq & 1);
        float acc[8];
#pragma unroll
        for (int k = 0; k < 8; ++k) acc[k] = 0.f;
        if (jj >= 0) { const float* pw = PW + (size_t)((g * 65 + jj) * 64) * 2; const float* cr = Cre + (g * 16 + c) * 64; const float* ci = Cim + (g * 16 + c) * 64; const float* bb = BB + (size_t)(g * 64) * 32 + c0 * 2;
#pragma unroll 4
            for (int p = 0; p < 64; ++p) { const float xr = cr[p] * pw[2 * p] - ci[p] * pw[2 * p + 1], xi = cr[p] * pw[2 * p + 1] + ci[p] * pw[2 * p]; const f32x4* b4 = (const f32x4*)(bb + p * 32);
#pragma unroll
                for (int k = 0; k < 4; ++k) { const f32x4 q = b4[k]; acc[2 * k] += xr * q.x - xi * q.y; acc[2 * k + 1] += xr * q.z - xi * q.w; } } }
        u32x4 o; o.x = pk2(acc[0], acc[1]); o.y = pk2(acc[2], acc[3]); o.z = pk2(acc[4], acc[5]); o.w = pk2(acc[6], acc[7]);
        *(u32x4*)(KP + (size_t)i * 8) = o; } }
    { bf16_t* FT = (bf16_t*)(ws + WS_FT);
      for (int i0 = gt; i0 < 32 * 64 * 4 * 64; i0 += 4 * NGT) { f32x4 pw4[4][4], cr4[4][2], ci4[4][2];
#pragma unroll
        for (int u = 0; u < 4; ++u) { const int i = i0 + u * NGT; if (i < 32 * 64 * 4 * 64) { const int ln = i & 63, ks = (i >> 6) & 3, t = (i >> 8) & 63, g = i >> 14; const int c = ln & 15, q0 = 32 * ks + 8 * (ln >> 4), p0 = q0 & 63;
            const f32x4* pw = (const f32x4*)(PW + (size_t)((g * 65 + t + 1) * 64 + p0) * 2); const f32x4* cr = (const f32x4*)(Cre + (g * 16 + c) * 64 + p0); const f32x4* ci = (const f32x4*)(Cim + (g * 16 + c) * 64 + p0);
            pw4[u][0] = pw[0]; pw4[u][1] = pw[1]; pw4[u][2] = pw[2]; pw4[u][3] = pw[3]; cr4[u][0] = cr[0]; cr4[u][1] = cr[1]; ci4[u][0] = ci[0]; ci4[u][1] = ci[1]; } }
#pragma unroll
        for (int u = 0; u < 4; ++u) { const int i = i0 + u * NGT; if (i < 32 * 64 * 4 * 64) { const int im = (32 * ((i >> 6) & 3) + 8 * ((i & 63) >> 4)) >= 64; float v[8];
#pragma unroll
            for (int k = 0; k < 8; ++k) { const float pr = pw4[u][k >> 1][2 * (k & 1)], pi = pw4[u][k >> 1][2 * (k & 1) + 1], cr = cr4[u][k >> 2][k & 3], ci = ci4[u][k >> 2][k & 3]; const float re = cr * pr - ci * pi, ig = cr * pi + ci * pr; v[k] = im ? -ig : re; }
            u32x4 o; o.x = pk2(v[0], v[1]); o.y = pk2(v[2], v[3]); o.z = pk2(v[4], v[5]); o.w = pk2(v[6], v[7]);
            *(u32x4*)(FT + (size_t)i * 8) = o; } } } }
    { bf16_t* ET = (bf16_t*)(ws + WS_ET);
      for (int i0 = gt; i0 < 32 * 8 * 32 * 64; i0 += 4 * NGT) { float pr4[4], pi4[4]; f32x4 bb4[4][4];
#pragma unroll
        for (int u = 0; u < 4; ++u) { const int i = i0 + u * NGT; if (i < 32 * 8 * 32 * 64) { const int ln = i & 63, ks = (i >> 6) & 31, rb = (i >> 11) & 7, g = i >> 14; const int q = 16 * rb + (ln & 15), p = q & 63, tau = 2 * ks + (ln >> 5), c0 = 8 * ((ln >> 4) & 1);
            pr4[u] = PW[(size_t)((g * 65 + 63 - tau) * 64 + p) * 2]; pi4[u] = PW[(size_t)((g * 65 + 63 - tau) * 64 + p) * 2 + 1]; const f32x4* bb = (const f32x4*)(BB + (size_t)((g * 64 + p) * 16 + c0) * 2);
            bb4[u][0] = bb[0]; bb4[u][1] = bb[1]; bb4[u][2] = bb[2]; bb4[u][3] = bb[3]; } }
#pragma unroll
        for (int u = 0; u < 4; ++u) { const int i = i0 + u * NGT; if (i < 32 * 8 * 32 * 64) { const int im = ((16 * ((i >> 11) & 7) + (i & 15)) >> 6) & 1; float v[8];
#pragma unroll
            for (int k = 0; k < 8; ++k) { const float br = bb4[u][k >> 1][2 * (k & 1)], bi = bb4[u][k >> 1][2 * (k & 1) + 1]; v[k] = im ? (pr4[u] * bi + pi4[u] * br) : (pr4[u] * br - pi4[u] * bi); }
            u32x4 o; o.x = pk2(v[0], v[1]); o.y = pk2(v[2], v[3]); o.z = pk2(v[4], v[5]); o.w = pk2(v[6], v[7]);
            *(u32x4*)(ET + (size_t)i * 8) = o; } } } }
}
__device__ __forceinline__ void p2_rows(ArgsRef A, int lane, int wave) {
    unsigned char* ws = A.ws; const int gw = blockIdx.x * 8 + wave, NGW = gridDim.x * 8;
    const bf16_t* H1 = (const bf16_t*)(ws + WS_H1); bf16_t* CQ = (bf16_t*)(ws + WS_CQ); bf16_t* CKV = (bf16_t*)(ws + WS_CKV);
    float* KROT = (float*)(ws + WS_KROT); float* ROTSS = (float*)(ws + WS_ROTSS); const float* RP = (const float*)(ws + WS_ROPE);
    for (int r0 = gw; r0 < MV; r0 += 2 * NGW) {
      u32x4 qw[2], kw[2]; unsigned pe1[2], pe2[2];
#pragma unroll
      for (int u = 0; u < 2; ++u) { const int r = r0 + u * NGW; qw[u] = (u32x4){0, 0, 0, 0}; kw[u] = (u32x4){0, 0, 0, 0}; pe1[u] = 0; pe2[u] = 0;
        if (r < MV) { const bf16_t* hrow = H1 + (size_t)r * NIN; if (lane < 48) qw[u] = *(const u32x4*)(hrow + lane * 8); if (lane < 32) kw[u] = *(const u32x4*)(hrow + 384 + lane * 8); if (lane < 16) { pe1[u] = hrow[1152 + lane]; pe2[u] = hrow[1168 + lane]; } } }
#pragma unroll
      for (int u = 0; u < 2; ++u) { const int r = r0 + u * NGW; if (r < MV) {
        int pos; size_t kvrow; float* okv; float* okr;
        if (r < MPR) { pos = r & 4095; kvrow = (size_t)r; okv = A.out + O_KVP + (size_t)r * 256; okr = A.out + O_KRP + (size_t)r * 32; }
        else { const int s = r - MPR, b = s >> 4, t = s & 15; pos = 2048 + t; kvrow = (size_t)(16384 + b * SKVB + 2048 + t); okv = A.out + O_KVS + (size_t)s * 256; okr = A.out + O_KRS + (size_t)s * 32; }
        { const u32x4 w = qw[u]; float v[8]; v[0] = bflo(w.x); v[1] = bfhi(w.x); v[2] = bflo(w.y); v[3] = bfhi(w.y); v[4] = bflo(w.z); v[5] = bfhi(w.z); v[6] = bflo(w.w); v[7] = bfhi(w.w); float ss = 0.f;
#pragma unroll
          for (int k = 0; k < 8; ++k) ss += v[k] * v[k];
          const float rs = rsqrtf(wave_sum(ss) * (1.f / 384.f) + EPSF);
          if (lane < 48) { const f32x4 g0 = *(const f32x4*)(A.in[9] + lane * 8), g1 = *(const f32x4*)(A.in[9] + lane * 8 + 4);
            u32x4 o; o.x = pk2(v[0] * rs * g0.x, v[1] * rs * g0.y); o.y = pk2(v[2] * rs * g0.z, v[3] * rs * g0.w); o.z = pk2(v[4] * rs * g1.x, v[5] * rs * g1.y); o.w = pk2(v[6] * rs * g1.z, v[7] * rs * g1.w);
            *(u32x4*)(CQ + (size_t)r * 384 + lane * 8) = o; } }
        { const u32x4 w = kw[u]; float v[8]; v[0] = bflo(w.x); v[1] = bfhi(w.x); v[2] = bflo(w.y); v[3] = bfhi(w.y); v[4] = bflo(w.z); v[5] = bfhi(w.z); v[6] = bflo(w.w); v[7] = bfhi(w.w); float ss = 0.f;
#pragma unroll
          for (int k = 0; k < 8; ++k) ss += v[k] * v[k];
          const float rs = rsqrtf(wave_sum(ss) * (1.f / 256.f) + EPSF);
          if (lane < 32) { const f32x4 g0 = *(const f32x4*)(A.in[11] + lane * 8), g1 = *(const f32x4*)(A.in[11] + lane * 8 + 4);
            f32x4 c0, c1; c0.x = v[0] * rs * g0.x; c0.y = v[1] * rs * g0.y; c0.z = v[2] * rs * g0.z; c0.w = v[3] * rs * g0.w; c1.x = v[4] * rs * g1.x; c1.y = v[5] * rs * g1.y; c1.z = v[6] * rs * g1.z; c1.w = v[7] * rs * g1.w;
            *(f32x4*)(okv + lane * 8) = c0; *(f32x4*)(okv + lane * 8 + 4) = c1;
            u32x4 o; o.x = pk2(c0.x, c0.y); o.y = pk2(c0.z, c0.w); o.z = pk2(c1.x, c1.y); o.w = pk2(c1.z, c1.w);
            *(u32x4*)(CKV + kvrow * 256 + lane * 8) = o; } }
        { float ss = 0.f;
          if (lane < 16) { const float x1 = __uint_as_float(pe1[u] << 16), x2 = __uint_as_float(pe2[u] << 16); const float c = RP[pos * 32 + lane], s = RP[pos * 32 + 16 + lane];
            const float o1 = x1 * c - x2 * s, o2 = x2 * c + x1 * s; okr[lane] = o1; okr[16 + lane] = o2; KROT[kvrow * 32 + lane] = o1; KROT[kvrow * 32 + 16 + lane] = o2; ss = o1 * o1 + o2 * o2; }
          ss = wave_sum(ss); if (lane == 0) ROTSS[kvrow] = ss; }
      } }
    }
}
__device__ __forceinline__ void p2_s5loc(ArgsRef A, int lane, int wave) {
    unsigned char* ws = A.ws; const int gw = blockIdx.x * 8 + wave, NGW = gridDim.x * 8;
    const bf16_t* H1 = (const bf16_t*)(ws + WS_H1); const bf16_t* ET = (const bf16_t*)(ws + WS_ET); float* SLOC = (float*)(ws + WS_SLOC);
    for (int w = gw; w < 2048; w += NGW) {
        const int g = w >> 6, ntile = (w >> 2) & 15, rq = w & 3, b = ntile >> 2, chunk = 16 * (ntile & 3) + (lane & 15), kq = lane >> 4;
        f32x4 acc0 = (f32x4){0.f, 0.f, 0.f, 0.f}, acc1 = (f32x4){0.f, 0.f, 0.f, 0.f};
        const bf16_t* ub = H1 + (size_t)(b * 4096 + chunk * 64 + (kq >> 1)) * NIN + 640 + g * 16 + 8 * (kq & 1);
        const bf16_t* e0 = ET + ((size_t)((g * 8 + 2 * rq) * 32) * 64 + lane) * 8; const bf16_t* e1 = e0 + (size_t)32 * 64 * 8;
#pragma unroll 8
        for (int ks = 0; ks < 32; ++ks) {
            const bf16x8 bf = *(const bf16x8*)(ub + (size_t)(2 * ks) * NIN), a0 = *(const bf16x8*)(e0 + (size_t)ks * 512), a1 = *(const bf16x8*)(e1 + (size_t)ks * 512);
            acc0 = __builtin_amdgcn_mfma_f32_16x16x32_bf16(a0, bf, acc0, 0, 0, 0); acc1 = __builtin_amdgcn_mfma_f32_16x16x32_bf16(a1, bf, acc1, 0, 0, 0);
        }
        float* o = SLOC + (size_t)((b * 32 + g) * 64 + chunk) * 128 + 32 * rq + 4 * kq;
        *(f32x4*)o = acc0; *(f32x4*)(o + 16) = acc1;
    }
}

struct EpiKV {
    static constexpr bool PERM = false, AFTER_DRAIN = false;
    ArgsRef A;
    __device__ __forceinline__ void operator()(const f32x4 (&acc)[2][2][4][2], const pg8::Unit& u, int wr, int wc, int fr, int fq) const {
        bf16_t* KB = (bf16_t*)(A.ws + WS_KB); bf16_t* VT = (bf16_t*)A.out; const float* KROT = (const float*)(A.ws + WS_KROT); const float* ROTSS = (const float*)(A.ws + WS_ROTSS); const float* gk = A.in[14];
        const int head = (u.pn & 1) * 4 + wc; const bool isv = u.pn >= 2;
        if (!isv) {
            f32x4 g4[2][2];
#pragma unroll
            for (int bj = 0; bj < 2; ++bj)
#pragma unroll
                for (int n = 0; n < 2; ++n) g4[bj][n] = *(const f32x4*)(gk + 32 * bj + 16 * n + 4 * fq);
            const f32x4 g0 = *(const f32x4*)(gk + 64 + 8 * fq), g1 = *(const f32x4*)(gk + 68 + 8 * fq);
#pragma unroll
            for (int ai = 0; ai < 2; ++ai) {
                float rss[4]; f32x4 r0[4], r1[4];
#pragma unroll
                for (int m = 0; m < 4; ++m) { const size_t row = (size_t)u.pm * 256 + ai * 128 + wr * 64 + m * 16 + fr; rss[m] = ROTSS[row]; r0[m] = *(const f32x4*)(KROT + row * 32 + 8 * fq); r1[m] = *(const f32x4*)(KROT + row * 32 + 8 * fq + 4); }
#pragma unroll
                for (int m = 0; m < 4; ++m) { const size_t row = (size_t)u.pm * 256 + ai * 128 + wr * 64 + m * 16 + fr; float ss = 0.f;
#pragma unroll
                    for (int bj = 0; bj < 2; ++bj)
#pragma unroll
                        for (int n = 0; n < 2; ++n) { const f32x4 x = acc[ai][bj][m][n]; ss += (x.x * x.x + x.y * x.y) + (x.z * x.z + x.w * x.w); }
                    ss += __shfl_xor(ss, 16); ss += __shfl_xor(ss, 32); ss += rss[m];
                    const float rs = rsqrtf(ss * (1.f / 96.f) + EPSF); bf16_t* kp = KB + ((size_t)head * MKV + row) * 96;
#pragma unroll
                    for (int bj = 0; bj < 2; ++bj)
#pragma unroll
                        for (int n = 0; n < 2; ++n) { const int d = 32 * bj + 16 * n + 4 * fq; const f32x4 x = acc[ai][bj][m][n]; const f32x4 g = g4[bj][n];
                            u32x2 w; w.x = pk2(x.x * rs * g.x, x.y * rs * g.y); w.y = pk2(x.z * rs * g.z, x.w * rs * g.w); *(u32x2*)(kp + d) = w; }
                    u32x4 w; w.x = pk2(r0[m].x * rs * g0.x, r0[m].y * rs * g0.y); w.y = pk2(r0[m].z * rs * g0.z, r0[m].w * rs * g0.w); w.z = pk2(r1[m].x * rs * g1.x, r1[m].y * rs * g1.y); w.w = pk2(r1[m].z * rs * g1.z, r1[m].w * rs * g1.w);
                    *(u32x4*)(kp + 64 + 8 * fq) = w; } }
        } else {
            const int q = fr & 3;
#pragma unroll
            for (int ai = 0; ai < 2; ++ai)
#pragma unroll
                for (int m = 0; m < 4; ++m) { const size_t row4 = (size_t)u.pm * 256 + ai * 128 + wr * 64 + m * 16 + (fr & ~3);
#pragma unroll
                    for (int bj = 0; bj < 2; ++bj)
#pragma unroll
                        for (int n = 0; n < 2; ++n) { const f32x4 x = acc[ai][bj][m][n];
                            const float s0 = (q & 1) ? x.x : x.y, s1 = (q & 1) ? x.z : x.w;
                            const float t0 = __shfl_xor(s0, 1), t1 = __shfl_xor(s1, 1);
                            const float a0 = (q & 1) ? t0 : x.x, a1 = (q & 1) ? x.y : t0, a2 = (q & 1) ? t1 : x.z, a3 = (q & 1) ? x.w : t1;
                            const float u0 = (q & 2) ? a0 : a2, u1 = (q & 2) ? a1 : a3;
                            const float v0 = __shfl_xor(u0, 2), v1 = __shfl_xor(u1, 2);
                            const float y0 = (q & 2) ? v0 : a0, y1 = (q & 2) ? v1 : a1, y2 = (q & 2) ? a2 : v0, y3 = (q & 2) ? a3 : v1;
                            const int dv = 32 * bj + 16 * n + 4 * fq + q; u32x2 w; w.x = pk2(y0, y1); w.y = pk2(y2, y3);
                            *(u32x2*)(VT + (size_t)(head * 64 + dv) * MKV + row4) = w; } }
        }
    }
};
struct EpiGLU {
    static constexpr bool PERM = true, AFTER_DRAIN = false;
    ArgsRef A;
    __device__ __forceinline__ void operator()(const f32x4 (&acc)[2][2][4][2], const pg8::Unit& u, int wr, int wc, int fr, int fq) const {
        const bf16_t* G = (const bf16_t*)(A.ws + WS_G); bf16_t* MIX = (bf16_t*)(A.ws + WS_MIX); const float* bias = A.in[24];
        f32x4 b0[2], b1[2];
#pragma unroll
        for (int bj = 0; bj < 2; ++bj) { const int col = u.pn * 256 + bj * 128 + wc * 32 + 8 * fq; b0[bj] = *(const f32x4*)(bias + col); b1[bj] = *(const f32x4*)(bias + col + 4); }
#pragma unroll
        for (int ai = 0; ai < 2; ++ai) { u32x4 gw[4][2];
#pragma unroll
            for (int m = 0; m < 4; ++m)
#pragma unroll
                for (int bj = 0; bj < 2; ++bj) { const size_t row = (size_t)u.pm * 256 + ai * 128 + wr * 64 + m * 16 + fr; gw[m][bj] = *(const u32x4*)(G + row * 512 + u.pn * 256 + bj * 128 + wc * 32 + 8 * fq); }
#pragma unroll
            for (int m = 0; m < 4; ++m)
#pragma unroll
                for (int bj = 0; bj < 2; ++bj) { const size_t row = (size_t)u.pm * 256 + ai * 128 + wr * 64 + m * 16 + fr; const int col = u.pn * 256 + bj * 128 + wc * 32 + 8 * fq;
                    const f32x4 z0 = acc[ai][bj][m][0] + b0[bj], z1 = acc[ai][bj][m][1] + b1[bj]; const u32x4 g = gw[m][bj];
                    u32x4 o; o.x = pk2(bflo(g.x) * sigmoidf_(z0.x), bfhi(g.x) * sigmoidf_(z0.y)); o.y = pk2(bflo(g.y) * sigmoidf_(z0.z), bfhi(g.y) * sigmoidf_(z0.w));
                    o.z = pk2(bflo(g.z) * sigmoidf_(z1.x), bfhi(g.z) * sigmoidf_(z1.y)); o.w = pk2(bflo(g.w) * sigmoidf_(z1.z), bfhi(g.w) * sigmoidf_(z1.w));
                    *(u32x4*)(MIX + row * 1024 + 512 + col) = o; } }
    }
};
struct EpiOut {
    static constexpr bool PERM = false, AFTER_DRAIN = false;
    ArgsRef A;
    __device__ __forceinline__ void operator()(const f32x4 (&acc)[2][2][4][2], const pg8::Unit& u, int wr, int wc, int fr, int fq) const {
        const float* xp = A.in[0]; float* out = A.out; bf16_t* HB = (bf16_t*)(A.ws + WS_HB); float* SS = (float*)(A.ws + WS_SS);
#pragma unroll
        for (int ai = 0; ai < 2; ++ai) { f32x4 xv[4][2][2];
#pragma unroll
            for (int m = 0; m < 4; ++m)
#pragma unroll
                for (int bj = 0; bj < 2; ++bj)
#pragma unroll
                    for (int n = 0; n < 2; ++n) { const size_t row = (size_t)u.pm * 256 + ai * 128 + wr * 64 + m * 16 + fr; xv[m][bj][n] = *(const f32x4*)(xp + row * 1024 + u.pn * 256 + bj * 128 + wc * 32 + 16 * n + 4 * fq); }
#pragma unroll
            for (int m = 0; m < 4; ++m) { const size_t row = (size_t)u.pm * 256 + ai * 128 + wr * 64 + m * 16 + fr; float ss = 0.f;
#pragma unroll
                for (int bj = 0; bj < 2; ++bj)
#pragma unroll
                    for (int n = 0; n < 2; ++n) { const int col = u.pn * 256 + bj * 128 + wc * 32 + 16 * n + 4 * fq; const f32x4 h = acc[ai][bj][m][n] + xv[m][bj][n];
                        *(f32x4*)(out + row * 1024 + col) = h; ss += (h.x * h.x + h.y * h.y) + (h.z * h.z + h.w * h.w); u32x2 w; w.x = pk2(h.x, h.y); w.y = pk2(h.z, h.w); *(u32x2*)(HB + row * 1024 + col) = w; }
                ss += __shfl_xor(ss, 16); ss += __shfl_xor(ss, 32); if (fq == 0) SS[row * 16 + u.pn * 4 + wc] = ss; } }
    }
};
struct EpiNull {
    static constexpr bool PERM = false, AFTER_DRAIN = false;
    ArgsRef A;
    __device__ __forceinline__ void operator()(const f32x4 (&acc)[2][2][4][2], const pg8::Unit& u, int wr, int wc, int fr, int fq) const {
        float s = 0.f;
#pragma unroll
        for (int ai = 0; ai < 2; ++ai)
#pragma unroll
            for (int bj = 0; bj < 2; ++bj)
#pragma unroll
                for (int m = 0; m < 4; ++m)
#pragma unroll
                    for (int n = 0; n < 2; ++n) s += acc[ai][bj][m][n].x + acc[ai][bj][m][n].y + acc[ai][bj][m][n].z + acc[ai][bj][m][n].w;
        if (s == 12345.678f) ((float*)(A.ws + WS_CTL))[1024] = s;
    }
};
struct EpiDown {
    static constexpr bool PERM = false, AFTER_DRAIN = false;
    ArgsRef A;
    __device__ __forceinline__ void operator()(const f32x4 (&acc)[2][2][4][2], const pg8::Unit& u, int wr, int wc, int fr, int fq) const {
        float* out = A.out;
#pragma unroll
        for (int ai = 0; ai < 2; ++ai) { f32x4 hv[4][2][2];
#pragma unroll
            for (int m = 0; m < 4; ++m)
#pragma unroll
                for (int bj = 0; bj < 2; ++bj)
#pragma unroll
                    for (int n = 0; n < 2; ++n) { const size_t row = (size_t)u.pm * 256 + ai * 128 + wr * 64 + m * 16 + fr; hv[m][bj][n] = *(const f32x4*)(out + row * 1024 + u.pn * 256 + bj * 128 + wc * 32 + 16 * n + 4 * fq); }
#pragma unroll
            for (int m = 0; m < 4; ++m)
#pragma unroll
                for (int bj = 0; bj < 2; ++bj)
#pragma unroll
                    for (int n = 0; n < 2; ++n) { const size_t row = (size_t)u.pm * 256 + ai * 128 + wr * 64 + m * 16 + fr; *(f32x4*)(out + row * 1024 + u.pn * 256 + bj * 128 + wc * 32 + 16 * n + 4 * fq) = hv[m][bj][n] + acc[ai][bj][m][n]; } }
    }
};
__device__ __forceinline__ float dpp_ror1(float v) { return __int_as_float(__builtin_amdgcn_mov_dpp(__float_as_int(v), 0x121, 0xf, 0xf, false)); }
__device__ __forceinline__ float dpp_ror2(float v) { return __int_as_float(__builtin_amdgcn_mov_dpp(__float_as_int(v), 0x122, 0xf, 0xf, false)); }
__device__ __forceinline__ float dpp_shr1(float old, float v) { return __int_as_float(__builtin_amdgcn_update_dpp(__float_as_int(old), __float_as_int(v), 0x111, 0xf, 0xf, false)); }
__device__ __forceinline__ float dpp_shr2(float old, float v) { return __int_as_float(__builtin_amdgcn_update_dpp(__float_as_int(old), __float_as_int(v), 0x112, 0xf, 0xf, false)); }
struct EpiUp {
    static constexpr bool PERM = false, AFTER_DRAIN = false;
    ArgsRef A; LAS float* xch;
    __device__ __forceinline__ void operator()(f32x4 (&acc)[2][2][4][2], const pg8::Unit& u, int wr, int wc, int fr, int fq) const {
        bf16_t* ACT = (bf16_t*)(A.ws + WS_ACT); float* SIDE = (float*)(A.ws + WS_SIDE); const float* SS = (const float*)(A.ws + WS_SS); const float* wdw = A.in[28]; const float* bdw = A.in[29]; const float* hist = A.in[6]; float* out = A.out;
        const int pm = u.pm, pn = u.pn; const bool sample = pm == 64; const int cw = 32 * wc + 4 * fq;
        f32x4 w0a[2][2], w1a[2][2], w2a[2][2], bba[2][2];
#pragma unroll
        for (int n = 0; n < 2; ++n)
#pragma unroll
            for (int bj = 0; bj < 2; ++bj) { const int sc = bj * 2816 + pn * 128 + cw + 16 * n; w0a[n][bj] = *(const f32x4*)(wdw + sc); w1a[n][bj] = *(const f32x4*)(wdw + 5632 + sc); w2a[n][bj] = *(const f32x4*)(wdw + 2 * 5632 + sc); bba[n][bj] = *(const f32x4*)(bdw + sc); }
#pragma unroll
        for (int ai = 0; ai < 2; ++ai)
#pragma unroll
            for (int m = 0; m < 4; ++m) { const size_t row = (size_t)pm * 256 + ai * 128 + wr * 64 + m * 16 + fr;
                float s;
                if (sample) { s = 256.f; if (ai == 0) { const f32x4* sq = (const f32x4*)((const float*)(A.ws + WS_SSS) + (row - MPR) * 64 + 16 * fq); s = 0.f;
#pragma unroll
                    for (int k = 0; k < 4; ++k) { const f32x4 q = sq[k]; s += (q.x + q.y) + (q.z + q.w); } } }
                else { const f32x4 a = *(const f32x4*)(SS + row * 16 + 4 * fq); s = (a.x + a.y) + (a.z + a.w); }
                s += __shfl_xor(s, 16); s += __shfl_xor(s, 32);
                const float rs = rsqrtf(s * (1.f / 1024.f) + EPSF);
#pragma unroll
                for (int bj = 0; bj < 2; ++bj)
#pragma unroll
                    for (int n = 0; n < 2; ++n) acc[ai][bj][m][n] *= rs; }
        if (fr >= 14) {
#pragma unroll
            for (int ai = 0; ai < 2; ++ai)
#pragma unroll
                for (int bj = 0; bj < 2; ++bj)
#pragma unroll
                    for (int n = 0; n < 2; ++n) *(LAS f32x4*)(xch + ((2 * ai + wr) * 2 + (fr - 14)) * 256 + 128 * bj + cw + 16 * n) = acc[ai][bj][3][n];
            if (wr == 1) {
#pragma unroll
                for (int bj = 0; bj < 2; ++bj)
#pragma unroll
                    for (int n = 0; n < 2; ++n) { *(f32x4*)(SIDE + (size_t)(pm * 4 + 2 + fr - 14) * 5632 + pn * 256 + 128 * bj + cw + 16 * n) = acc[1][bj][3][n];
                        if (!sample && (pm & 15) == 15) *(f32x4*)(out + O_CONVP + (size_t)((pm >> 4) * 2 + fr - 14) * 5632 + bj * 2816 + pn * 128 + cw + 16 * n) = acc[1][bj][3][n]; } }
            if (sample) {
#pragma unroll
                for (int m = 0; m < 4; ++m)
#pragma unroll
                    for (int bj = 0; bj < 2; ++bj)
#pragma unroll
                        for (int n = 0; n < 2; ++n) *(f32x4*)(out + O_CONVS + (size_t)((4 * wr + m) * 2 + fr - 14) * 5632 + bj * 2816 + pn * 128 + cw + 16 * n) = acc[0][bj][m][n]; }
        }
        if (fr < 2 && wr == 0) {
#pragma unroll
            for (int bj = 0; bj < 2; ++bj)
#pragma unroll
                for (int n = 0; n < 2; ++n) *(f32x4*)(SIDE + (size_t)(pm * 4 + fr) * 5632 + pn * 256 + 128 * bj + cw + 16 * n) = acc[0][bj][0][n]; }
        asm volatile("s_waitcnt lgkmcnt(0)\n\ts_barrier" ::: "memory");
        const bool t14 = fr >= 14;
#pragma unroll
        for (int n = 0; n < 2; ++n) {
            f32x4 w0[2], w1[2], w2[2], bb[2];
#pragma unroll
            for (int bj = 0; bj < 2; ++bj) { w0[bj] = w0a[n][bj]; w1[bj] = w1a[n][bj]; w2[bj] = w2a[n][bj]; bb[bj] = bba[n][bj]; }
#pragma unroll
            for (int ai = 0; ai < 2; ++ai)
#pragma unroll
                for (int m = 0; m < 4; ++m) { const size_t row = (size_t)pm * 256 + ai * 128 + wr * 64 + m * 16 + fr; f32x4 cv[2];
#pragma unroll
                    for (int bj = 0; bj < 2; ++bj) { f32x4 prev = (f32x4){0.f, 0.f, 0.f, 0.f};
                        if (sample) { if (t14 && ai == 0) prev = *(const f32x4*)(hist + (size_t)((4 * wr + m) * 2 + fr - 14) * 5632 + bj * 2816 + pn * 128 + cw + 16 * n); }
                        else if (m > 0) prev = acc[ai][bj][m > 0 ? m - 1 : 0][n];
                        else if (2 * ai + wr > 0) { if (t14) prev = *(const LAS f32x4*)(xch + ((2 * ai + wr - 1) * 2 + (fr - 14)) * 256 + 128 * bj + cw + 16 * n); }
                        const f32x4 cur = acc[ai][bj][m][n]; f32x4 p1, p2;
#pragma unroll
                        for (int j = 0; j < 4; ++j) { p1[j] = dpp_shr1(dpp_ror1(prev[j]), cur[j]); p2[j] = dpp_shr2(dpp_ror2(prev[j]), cur[j]); }
                        cv[bj] = w0[bj] * p2 + (w1[bj] * p1 + (w2[bj] * cur + bb[bj])); }
                    u32x2 w; w.x = pk2(cv[0].x * sigmoidf_(cv[0].x) * cv[1].x, cv[0].y * sigmoidf_(cv[0].y) * cv[1].y); w.y = pk2(cv[0].z * sigmoidf_(cv[0].z) * cv[1].z, cv[0].w * sigmoidf_(cv[0].w) * cv[1].w);
                    *(u32x2*)(ACT + row * 2816 + pn * 128 + cw + 16 * n) = w; }
        }
    }
};
__device__ __forceinline__ int crow(int r, int hi) { return (r & 3) + 8 * (r >> 2) + 4 * hi; }
__device__ __forceinline__ bf16x8 pack8(const f32x16& p, int b) {
    u32x4 w; w.x = pk2(p[b + 0], p[b + 1]); w.y = pk2(p[b + 2], p[b + 3]); w.z = pk2(p[b + 4], p[b + 5]); w.w = pk2(p[b + 6], p[b + 7]); return __builtin_bit_cast(bf16x8, w);
}
constexpr int AT_KROW = 208, AT_VROW = 136, AT_KB = 13312, AT_V0 = 4 * 13312, AT_VB = 8704;
__device__ __forceinline__ float max3f(float a, float b, float c) { float r; asm("v_max3_f32 %0, %1, %2, %3" : "=v"(r) : "v"(a), "v"(b), "v"(c)); return r; }
__device__ __forceinline__ void attn_unit(const int AV, ArgsRef A, bool sample, int b, int h, int qb, LAS unsigned char* lds, int tid, int lane, int wave) {
    unsigned char* ws = A.ws;
    const bf16_t* QRAW = (const bf16_t*)(ws + WS_QRAW); const bf16_t* KB = (const bf16_t*)(ws + WS_KB); const bf16_t* VT = (const bf16_t*)A.out; bf16_t* MIX = (bf16_t*)(ws + WS_MIX);
    const float* RP = (const float*)(ws + WS_ROPE); const float* gq = A.in[13];
    const int r32 = lane & 31, hi = lane >> 5;
    int NT, myNT, kvbase, qrow, pos, kvalid;
    if (sample) { NT = 33; myNT = wave == 0 ? 33 : 0; kvbase = 16384 + b * SKVB; qrow = MPR + 16 * b + (r32 & 15); pos = 2048 + (r32 & 15); kvalid = 16; }
    else { const int q0 = 256 * qb + 32 * wave; NT = 4 * qb + 4; myNT = (q0 >> 6) + 1; kvbase = b * 4096; qrow = b * 4096 + q0 + r32; pos = q0 + r32; kvalid = 64; }
    bf16x8 qf[6];
    const bf16_t* kg = KB + ((size_t)h * MKV + kvbase) * 96;
    const bf16_t* vg = VT + (size_t)(h * 64 + (tid >> 3)) * MKV + kvbase + 8 * (tid & 7);
    const int kd0 = (tid / 12) * AT_KROW + (tid % 12) * 16, kd1 = ((tid + 512) / 12) * AT_KROW + ((tid + 512) % 12) * 16, vd = AT_V0 + (tid >> 3) * AT_VROW + (tid & 7) * 16;
    u32x4 ka0, ka1 = (u32x4){0, 0, 0, 0}, va = (u32x4){0, 0, 0, 0}, kb0 = (u32x4){0, 0, 0, 0}, kb1 = (u32x4){0, 0, 0, 0}, vb_ = (u32x4){0, 0, 0, 0};
#define AT_LDK(t_, R0, R1) do { const bf16_t* kt_ = kg + (size_t)(t_) * 64 * 96; R0 = *(const u32x4*)(kt_ + tid * 8); if (tid < 256) R1 = *(const u32x4*)(kt_ + (tid + 512) * 8); } while (0)
#define AT_STK(slot_, R0, R1) do { *(LAS u32x4*)(lds + (slot_) * AT_KB + kd0) = R0; if (tid < 256) *(LAS u32x4*)(lds + (slot_) * AT_KB + kd1) = R1; } while (0)
#define AT_LDV(t_, RV) do { RV = *(const u32x4*)(vg + (t_) * 64); } while (0)
#define AT_STV(slot_, RV) do { *(LAS u32x2*)(lds + (slot_) * AT_VB + vd) = (u32x2){RV.x, RV.y}; *(LAS u32x2*)(lds + (slot_) * AT_VB + vd + 8) = (u32x2){RV.z, RV.w}; } while (0)
#define AT_QK(slot_, S0, S1) do { const LAS unsigned char* kb_ = lds + (slot_) * AT_KB + r32 * AT_KROW + hi * 16; \
        _Pragma("unroll") for (int d0 = 0; d0 < 6; ++d0) { const bf16x8 k0_ = *(const LAS bf16x8*)(kb_ + d0 * 32), k1_ = *(const LAS bf16x8*)(kb_ + 32 * AT_KROW + d0 * 32); \
            if (d0 == 0) { S0 = __builtin_amdgcn_mfma_f32_32x32x16_bf16(k0_, qf[0], zero16, 0, 0, 0); S1 = __builtin_amdgcn_mfma_f32_32x32x16_bf16(k1_, qf[0], zero16, 0, 0, 0); } \
            else { S0 = __builtin_amdgcn_mfma_f32_32x32x16_bf16(k0_, qf[d0], S0, 0, 0, 0); S1 = __builtin_amdgcn_mfma_f32_32x32x16_bf16(k1_, qf[d0], S1, 0, 0, 0); } } } while (0)
#define AT_MASK(S0, S1) do { _Pragma("unroll") for (int r = 0; r < 16; ++r) { if (crow(r, hi) >= kvalid) S0[r] = -1e30f; S1[r] = -1e30f; } } while (0)
    AT_LDK(0, ka0, ka1); AT_LDV(0, va); if (NT > 1) AT_LDK(1, kb0, kb1);
    { float v[6][8]; const bf16_t* qp = QRAW + (size_t)qrow * 768 + h * 96 + hi * 8;
#pragma unroll
      for (int d0 = 0; d0 < 6; ++d0) { const u32x4 w = *(const u32x4*)(qp + d0 * 16); v[d0][0] = bflo(w.x); v[d0][1] = bfhi(w.x); v[d0][2] = bflo(w.y); v[d0][3] = bfhi(w.y); v[d0][4] = bflo(w.z); v[d0][5] = bfhi(w.z); v[d0][6] = bflo(w.w); v[d0][7] = bfhi(w.w); }
      const float* rp = RP + pos * 32 + hi * 8; float ss = 0.f;
#pragma unroll
      for (int i = 0; i < 8; ++i) { const float c = rp[i], s = rp[16 + i], x1 = v[4][i], x2 = v[5][i]; v[4][i] = x1 * c - x2 * s; v[5][i] = x2 * c + x1 * s; }
#pragma unroll
      for (int d0 = 0; d0 < 6; ++d0)
#pragma unroll
          for (int i = 0; i < 8; ++i) ss += v[d0][i] * v[d0][i];
      ss += __shfl_xor(ss, 32);
      const float rs = rsqrtf(ss * (1.f / 96.f) + EPSF) * (0.10206207261596575f * 1.4426950408889634f);
#pragma unroll
      for (int d0 = 0; d0 < 6; ++d0) { const f32x4 g0 = *(const f32x4*)(gq + d0 * 16 + hi * 8), g1 = *(const f32x4*)(gq + d0 * 16 + hi * 8 + 4);
          u32x4 w; w.x = pk2(v[d0][0] * rs * g0.x, v[d0][1] * rs * g0.y); w.y = pk2(v[d0][2] * rs * g0.z, v[d0][3] * rs * g0.w); w.z = pk2(v[d0][4] * rs * g1.x, v[d0][5] * rs * g1.y); w.w = pk2(v[d0][6] * rs * g1.z, v[d0][7] * rs * g1.w);
          qf[d0] = __builtin_bit_cast(bf16x8, w); } }
    AT_STK(0, ka0, ka1); AT_STV(0, va); if (NT > 1) AT_STK(1, kb0, kb1);
    if (NT > 2) AT_LDK(2, kb0, kb1);
    if (NT > 1) AT_LDV(1, vb_);
    __syncthreads();
    float lrun = 0.f; f32x16 o0, o1, zero16, sa0, sa1, sb0, sb1;
#pragma unroll
    for (int r = 0; r < 16; ++r) { o0[r] = 0.f; o1[r] = 0.f; zero16[r] = 0.f; sa0[r] = 0.f; sa1[r] = 0.f; sb0[r] = 0.f; sb1[r] = 0.f; }
    if (myNT > 0) { AT_QK(0, sa0, sa1); if (NT == 1 && kvalid < 64) AT_MASK(sa0, sa1); }
    int vs3 = 0;
#define AT_COMPUTE(SC0, SC1, SN0, SN1) do { if (t < myNT) { \
              \
            bf16x8 kf_[12]; s16x4 vf_[16]; \
            { const LAS unsigned char* kb_ = lds + ((t + 1) & 3) * AT_KB + r32 * AT_KROW + hi * 16; \
              _Pragma("unroll") for (int d0 = 0; d0 < 6; ++d0) { kf_[2 * d0] = *(const LAS bf16x8*)(kb_ + d0 * 32); kf_[2 * d0 + 1] = *(const LAS bf16x8*)(kb_ + 32 * AT_KROW + d0 * 32); } \
            } \
            __builtin_amdgcn_sched_barrier(0); \
              \
            SN0 = __builtin_amdgcn_mfma_f32_32x32x16_bf16(kf_[0], qf[0], zero16, 0, 0, 0); SN1 = __builtin_amdgcn_mfma_f32_32x32x16_bf16(kf_[1], qf[0], zero16, 0, 0, 0); \
            _Pragma("unroll") for (int d0 = 1; d0 < 6; ++d0) { SN0 = __builtin_amdgcn_mfma_f32_32x32x16_bf16(kf_[2 * d0], qf[d0], SN0, 0, 0, 0); SN1 = __builtin_amdgcn_mfma_f32_32x32x16_bf16(kf_[2 * d0 + 1], qf[d0], SN1, 0, 0, 0); } \
            { const LAS unsigned char* vb = lds + AT_V0 + vs3 * AT_VB + r32 * AT_VROW + hi * 8; \
              _Pragma("unroll") for (int s = 0; s < 4; ++s) { const int kb2 = (32 * (s >> 1) + 16 * (s & 1)) * 2; \
                  vf_[4 * s] = *(const LAS s16x4*)(vb + kb2); vf_[4 * s + 1] = *(const LAS s16x4*)(vb + kb2 + 16); vf_[4 * s + 2] = *(const LAS s16x4*)(vb + 32 * AT_VROW + kb2); vf_[4 * s + 3] = *(const LAS s16x4*)(vb + 32 * AT_VROW + kb2 + 16); } } \
            float ps_ = 0.f; \
            _Pragma("unroll") for (int r = 0; r < 16; ++r) { if (AV != 3) { SC0[r] = __builtin_amdgcn_exp2f(SC0[r]); SC1[r] = __builtin_amdgcn_exp2f(SC1[r]); } ps_ += SC0[r] + SC1[r]; } \
            lrun += ps_; \
            bf16x8 pf[4]; pf[0] = pack8(SC0, 0); pf[1] = pack8(SC0, 8); pf[2] = pack8(SC1, 0); pf[3] = pack8(SC1, 8); \
            _Pragma("unroll") for (int i = 0; i < 12; ++i) { __builtin_amdgcn_sched_group_barrier(0x008, 1, 0); __builtin_amdgcn_sched_group_barrier(0x002, 7, 0); } \
            __builtin_amdgcn_sched_barrier(0); \
              \
            _Pragma("unroll") for (int s = 0; s < 4; ++s) { \
                const bf16x8 a0 = (bf16x8){vf_[4 * s][0], vf_[4 * s][1], vf_[4 * s][2], vf_[4 * s][3], vf_[4 * s + 1][0], vf_[4 * s + 1][1], vf_[4 * s + 1][2], vf_[4 * s + 1][3]}; \
                const bf16x8 a1 = (bf16x8){vf_[4 * s + 2][0], vf_[4 * s + 2][1], vf_[4 * s + 2][2], vf_[4 * s + 2][3], vf_[4 * s + 3][0], vf_[4 * s + 3][1], vf_[4 * s + 3][2], vf_[4 * s + 3][3]}; \
                o0 = __builtin_amdgcn_mfma_f32_32x32x16_bf16(a0, pf[s], o0, 0, 0, 0); o1 = __builtin_amdgcn_mfma_f32_32x32x16_bf16(a1, pf[s], o1, 0, 0, 0); } \
            if (t + 2 == NT && kvalid < 64) AT_MASK(SN0, SN1); } } while (0)
#define AT_ITER(RK0, RK1, RV, WK0, WK1, WV, SC0, SC1, SN0, SN1) do { \
        if (AV != 2 && t + 3 < NT) AT_LDK(t + 3, RK0, RK1); \
        if (AV != 2 && t + 2 < NT) AT_LDV(t + 2, RV); \
        asm volatile("" ::: "memory"); \
        AT_COMPUTE(SC0, SC1, SN0, SN1); \
        asm volatile("" ::: "memory"); \
        if (AV != 2 && t + 2 < NT) AT_STK((t + 2) & 3, WK0, WK1); \
        if (AV != 2 && t + 1 < NT) AT_STV(vs3 == 2 ? 0 : vs3 + 1, WV); \
        if (AV != 5) __syncthreads(); \
        vs3 = vs3 == 2 ? 0 : vs3 + 1; } while (0)
    for (int t0 = 0; t0 < NT; t0 += 2) {
        { const int t = t0; AT_ITER(ka0, ka1, va, kb0, kb1, vb_, sa0, sa1, sb0, sb1); }
        if (t0 + 1 < NT) { const int t = t0 + 1; AT_ITER(kb0, kb1, vb_, ka0, ka1, va, sb0, sb1, sa0, sa1); }
    }
#undef AT_ITER
#undef AT_COMPUTE
#undef AT_LDK
#undef AT_STK
#undef AT_LDV
#undef AT_STV
#undef AT_QK
#undef AT_MASK
    if (myNT > 0) {
        lrun += __shfl_xor(lrun, 32); const float inv = __builtin_amdgcn_rcpf(lrun);
        if (AV == 0 || lrun == 1234.5f) if (!sample || r32 < 16) { bf16_t* op = MIX + (size_t)qrow * 1024 + h * 64 + 4 * hi;
#pragma unroll
            for (int g4 = 0; g4 < 4; ++g4) { u32x2 w; w.x = pk2(o0[4 * g4] * inv, o0[4 * g4 + 1] * inv); w.y = pk2(o0[4 * g4 + 2] * inv, o0[4 * g4 + 3] * inv); *(u32x2*)(op + 8 * g4) = w;
                w.x = pk2(o1[4 * g4] * inv, o1[4 * g4 + 1] * inv); w.y = pk2(o1[4 * g4 + 2] * inv, o1[4 * g4 + 3] * inv); *(u32x2*)(op + 32 + 8 * g4) = w; } }
    }
}
__device__ __forceinline__ void s5y_item(ArgsRef A, int item, LAS unsigned char* lds, int tid, int lane, int wave) {
    unsigned char* ws = A.ws; const int g = item >> 3, ntp = item & 7, b = ntp >> 1;
    const bf16_t* H1 = (const bf16_t*)(ws + WS_H1); const bf16_t* KP = (const bf16_t*)(ws + WS_KP); const bf16_t* FT = (const bf16_t*)(ws + WS_FT); const float* SLOC = (const float*)(ws + WS_SLOC); const float* PW = (const float*)(ws + WS_POW);
    bf16_t* G = (bf16_t*)(ws + WS_G);
    const int ntl = wave >> 2, tq = wave & 3, ntile = 2 * ntp + ntl, n = lane & 15, kq = lane >> 4, chunk = 16 * (ntile & 3) + n, nks = 8 * tq + 8;
    const size_t row0 = (size_t)b * 4096 + (size_t)chunk * 64;
    const bf16_t* ubq = H1 + (row0 + (kq >> 1)) * NIN + 640 + g * 16 + 8 * (kq & 1);
    u32x4 st[12]; bf16x8 cur[8], nxt[8]; float lr = 0.f, li = 0.f;
    { const u32x4* s1 = (const u32x4*)(KP + (size_t)g * 64 * 512); const u32x4* s2 = (const u32x4*)(SLOC + (size_t)((b * 32 + g) * 64) * 128);
#pragma unroll
      for (int i = 0; i < 8; ++i) st[i] = s1[i * 512 + tid];
#pragma unroll
      for (int i = 0; i < 4; ++i) st[8 + i] = s2[i * 512 + tid]; }
#pragma unroll
    for (int i = 0; i < 8; ++i) { cur[i] = *(const bf16x8*)(ubq + (size_t)(2 * i) * NIN); nxt[i] = cur[i]; }
    if (wave < 2) { lr = PW[(size_t)((g * 65 + 64) * 64 + lane) * 2]; li = PW[(size_t)((g * 65 + 64) * 64 + lane) * 2 + 1]; }
#pragma unroll
    for (int i = 0; i < 8; ++i) *(LAS u32x4*)(lds + (size_t)(i * 512 + tid) * 16) = st[i];
#pragma unroll
    for (int i = 0; i < 4; ++i) *(LAS u32x4*)(lds + 81920 + (size_t)(i * 512 + tid) * 16) = st[8 + i];
    __syncthreads();
    if (wave < 2) { const int nt2 = 2 * ntp + wave, c0 = 16 * (nt2 & 3), p = lane;
        const LAS float* sl = (const LAS float*)(lds + 81920); float sr = 0.f, si = 0.f;
        for (int j = 0; j < c0; ++j) { const float ar = sl[j * 128 + p], ai = sl[j * 128 + 64 + p]; const float nr = lr * sr - li * si + ar, ni = lr * si + li * sr + ai; sr = nr; si = ni; }
        LAS bf16_t* sin = (LAS bf16_t*)(lds + 65536 + wave * 4352);
        for (int jj = 0; jj < 16; ++jj) { sin[jj * 136 + p] = (bf16_t)(pk2(sr, 0.f) & 0xffffu); sin[jj * 136 + 64 + p] = (bf16_t)(pk2(si, 0.f) & 0xffffu);
            const int j = c0 + jj; const float ar = sl[j * 128 + p], ai = sl[j * 128 + 64 + p]; const float nr = lr * sr - li * si + ar, ni = lr * si + li * sr + ai; sr = nr; si = ni; }
        if ((nt2 & 3) == 3) { int p2 = p; asm volatile("" : "+v"(p2)); A.out[O_S5RP + (size_t)(b * 32 + g) * 64 + p2] = sr; A.out[O_S5IP + (size_t)(b * 32 + g) * 64 + p2] = si; } }
    f32x4 acc[16];
#pragma unroll
    for (int i = 0; i < 16; ++i) acc[i] = (f32x4){0.f, 0.f, 0.f, 0.f};
    for (int kb = 0; kb < nks; kb += 8) {
        if (kb + 8 < nks) {
#pragma unroll
            for (int i = 0; i < 8; ++i) nxt[i] = *(const bf16x8*)(ubq + (size_t)(2 * (kb + 8 + i)) * NIN); }
#pragma unroll
        for (int i = 0; i < 8; ++i) { bf16x8 af[16];
#pragma unroll
            for (int tt = 0; tt < 16; ++tt) { const int j = 16 * tq + tt - 2 * (kb + i); af[tt] = *(const LAS bf16x8*)(lds + (j >= 0 ? j : 0) * 1024 + lane * 16); }
            __builtin_amdgcn_sched_barrier(0);
#pragma unroll
            for (int tt = 0; tt < 16; ++tt) { const int j = 16 * tq + tt - 2 * (kb + i); if (j >= 0) acc[tt] = __builtin_amdgcn_mfma_f32_16x16x32_bf16(af[tt], cur[i], acc[tt], 0, 0, 0); }
            __builtin_amdgcn_sched_barrier(0); }
#pragma unroll
        for (int i = 0; i < 8; ++i) cur[i] = nxt[i];
    }
    const bf16_t* fq_ = FT + ((size_t)((g * 64 + 16 * tq) * 4) * 64 + lane) * 8;
    bf16x8 fa[2][16];
#pragma unroll
    for (int tt = 0; tt < 16; ++tt) fa[0][tt] = *(const bf16x8*)(fq_ + (size_t)(tt * 4 + 0) * 512);
    __syncthreads();
    const f32x4 dv = *(const f32x4*)(A.in[22] + g * 16 + 4 * kq); u32x2 uw[16];
#pragma unroll
    for (int ks = 0; ks < 4; ++ks) {
        if (ks < 3) {
#pragma unroll
            for (int tt = 0; tt < 16; ++tt) fa[(ks + 1) & 1][tt] = *(const bf16x8*)(fq_ + (size_t)(tt * 4 + ks + 1) * 512); }
        else {
#pragma unroll
            for (int tt = 0; tt < 16; ++tt) uw[tt] = *(const u32x2*)(H1 + (row0 + 16 * tq + tt) * NIN + 640 + g * 16 + 4 * kq); }
        const bf16x8 bs = *(const LAS bf16x8*)(lds + 65536 + ntl * 4352 + n * 272 + (32 * ks + 8 * kq) * 2);
#pragma unroll
        for (int tt = 0; tt < 16; ++tt) acc[tt] = __builtin_amdgcn_mfma_f32_16x16x32_bf16(fa[ks & 1][tt], bs, acc[tt], 0, 0, 0);
    }
#pragma unroll
    for (int tt = 0; tt < 16; ++tt) { const size_t row = row0 + 16 * tq + tt;
        const float y0 = acc[tt].x + dv.x * bflo(uw[tt].x), y1 = acc[tt].y + dv.y * bfhi(uw[tt].x), y2 = acc[tt].z + dv.z * bflo(uw[tt].y), y3 = acc[tt].w + dv.w * bfhi(uw[tt].y);
        u32x2 w; w.x = pk2(gelu_tanh(y0), gelu_tanh(y1)); w.y = pk2(gelu_tanh(y2), gelu_tanh(y3)); *(u32x2*)(G + row * 512 + g * 16 + 4 * kq) = w; }
}
__device__ __forceinline__ void s5s_item(ArgsRef A, int item, LAS unsigned char* lds, int lane, int wave) {
    unsigned char* ws = A.ws; const int pair = item * 8 + wave, b = pair >> 5, g = pair & 31, p = lane;
    const bf16_t* H1 = (const bf16_t*)(ws + WS_H1); const float* PW = (const float*)(ws + WS_POW); const float* BB = (const float*)(ws + WS_BB); bf16_t* G = (bf16_t*)(ws + WS_G);
    LAS float* sb = (LAS float*)(lds + wave * 9216);
    float sr = A.in[4][(size_t)(b * 32 + g) * 64 + p], si = A.in[5][(size_t)(b * 32 + g) * 64 + p];
    const float lr = PW[(size_t)((g * 65 + 1) * 64 + p) * 2], li = PW[(size_t)((g * 65 + 1) * 64 + p) * 2 + 1];
    f32x4 bq[8];
#pragma unroll
    for (int i = 0; i < 8; ++i) bq[i] = *(const f32x4*)(BB + (size_t)((g * 64 + p) * 16) * 2 + 4 * i);
    LAS unsigned* ub = (LAS unsigned*)(lds + 73728 + wave * 512);
    if (lane < 32) { const u32x4 uv = *(const u32x4*)(H1 + (size_t)(MPR + 16 * b + (lane >> 1)) * NIN + 640 + g * 16 + 8 * (lane & 1)); *(LAS u32x4*)(ub + lane * 4) = uv; }
    LDS_WAIT();
    for (int t = 0; t < 16; ++t) { const u32x4 u0 = *(const LAS u32x4*)(ub + t * 8), u1 = *(const LAS u32x4*)(ub + t * 8 + 4);
        float uu[16]; uu[0] = bflo(u0.x); uu[1] = bfhi(u0.x); uu[2] = bflo(u0.y); uu[3] = bfhi(u0.y); uu[4] = bflo(u0.z); uu[5] = bfhi(u0.z); uu[6] = bflo(u0.w); uu[7] = bfhi(u0.w);
        uu[8] = bflo(u1.x); uu[9] = bfhi(u1.x); uu[10] = bflo(u1.y); uu[11] = bfhi(u1.y); uu[12] = bflo(u1.z); uu[13] = bfhi(u1.z); uu[14] = bflo(u1.w); uu[15] = bfhi(u1.w);
        float br = 0.f, bi = 0.f;
#pragma unroll
        for (int i = 0; i < 8; ++i) { br += bq[i].x * uu[2 * i] + bq[i].z * uu[2 * i + 1]; bi += bq[i].y * uu[2 * i] + bq[i].w * uu[2 * i + 1]; }
        const float nr = lr * sr - li * si + br, ni = lr * si + li * sr + bi; sr = nr; si = ni; sb[t * 132 + p] = sr; sb[t * 132 + 64 + p] = si; }
    A.out[O_S5RS + (size_t)(b * 32 + g) * 64 + p] = sr; A.out[O_S5IS + (size_t)(b * 32 + g) * 64 + p] = si;
    LDS_WAIT();
    { const int l16 = lane & 15, kq = lane >> 4; f32x4 yacc = (f32x4){0.f, 0.f, 0.f, 0.f};
#pragma unroll
      for (int ks = 0; ks < 4; ++ks) { const int q0 = 32 * ks + 8 * kq; const bool im = q0 >= 64; const float* cp = (im ? A.in[21] : A.in[20]) + (size_t)(g * 16 + l16) * 64 + (q0 & 63);
          const f32x4 c0 = *(const f32x4*)cp, c1 = *(const f32x4*)(cp + 4); const float sg = im ? -1.f : 1.f;
          u32x4 aw; aw.x = pk2(sg * c0.x, sg * c0.y); aw.y = pk2(sg * c0.z, sg * c0.w); aw.z = pk2(sg * c1.x, sg * c1.y); aw.w = pk2(sg * c1.z, sg * c1.w);
          const f32x4 s0 = *(const LAS f32x4*)(sb + l16 * 132 + q0), s1 = *(const LAS f32x4*)(sb + l16 * 132 + q0 + 4);
          u32x4 bw; bw.x = pk2(s0.x, s0.y); bw.y = pk2(s0.z, s0.w); bw.z = pk2(s1.x, s1.y); bw.w = pk2(s1.z, s1.w);
          yacc = __builtin_amdgcn_mfma_f32_16x16x32_bf16(__builtin_bit_cast(bf16x8, aw), __builtin_bit_cast(bf16x8, bw), yacc, 0, 0, 0); }
      const int t = l16, c0i = 4 * kq; const size_t row = (size_t)(MPR + 16 * b + t); const u32x2 uw = *(const u32x2*)(H1 + row * NIN + 640 + g * 16 + c0i); const f32x4 dv = *(const f32x4*)(A.in[22] + g * 16 + c0i);
      const float y0 = yacc.x + dv.x * bflo(uw.x), y1 = yacc.y + dv.y * bfhi(uw.x), y2 = yacc.z + dv.z * bflo(uw.y), y3 = yacc.w + dv.w * bfhi(uw.y);
      u32x2 w; w.x = pk2(gelu_tanh(y0), gelu_tanh(y1)); w.y = pk2(gelu_tanh(y2), gelu_tanh(y3)); *(u32x2*)(G + row * 512 + g * 16 + c0i) = w; }
    LDS_WAIT();
}
template <int KSW, bool IS_OUT>
__device__ __forceinline__ void skinny_pair(ArgsRef A, int it0, LAS unsigned char* lds, int lane, int wave) {
    unsigned char* ws = A.ws; const int l16 = lane & 15, kq = lane >> 4; constexpr int K = IS_OUT ? 1024 : 2816;
    const bf16_t* Am = (const bf16_t*)(ws + (IS_OUT ? WS_MIX : WS_ACT)); const bf16_t* Bm = (const bf16_t*)(ws + (IS_OUT ? WS_WOUT : WS_WDN));
    const int myit = it0 + 256 * (wave & 1), mcg = myit & 63, mrg = myit >> 6, mcol = 16 * mcg + l16;
    float res[4] = {0.f, 0.f, 0.f, 0.f};
    if (wave < 2) {
#pragma unroll
        for (int i = 0; i < 4; ++i) { const int sr = 16 * mrg + 4 * kq + i; res[i] = IS_OUT ? A.in[1][(size_t)sr * 1024 + mcol] : A.out[(size_t)(MPR + sr) * 1024 + mcol]; } }
    f32x4 acc[2];
    if constexpr (KSW <= 4) {
        bf16x8 av[2][KSW], bv[2][KSW];
#pragma unroll
        for (int j = 0; j < 2; ++j) { const int it = it0 + 256 * j, cg_ = it & 63, rg = it >> 6;
            const bf16_t* ap = Am + (size_t)(MPR + 16 * rg + l16) * K + 8 * kq + wave * KSW * 32; const bf16_t* bp = Bm + (size_t)(16 * cg_ + l16) * K + 8 * kq + wave * KSW * 32;
#pragma unroll
            for (int ks = 0; ks < KSW; ++ks) { av[j][ks] = *(const bf16x8*)(ap + 32 * ks); bv[j][ks] = *(const bf16x8*)(bp + 32 * ks); } }
#pragma unroll
        for (int j = 0; j < 2; ++j) { acc[j] = (f32x4){0.f, 0.f, 0.f, 0.f};
#pragma unroll
            for (int ks = 0; ks < KSW; ++ks) acc[j] = __builtin_amdgcn_mfma_f32_16x16x32_bf16(av[j][ks], bv[j][ks], acc[j], 0, 0, 0); }
    } else {
#pragma unroll
        for (int j = 0; j < 2; ++j) { const int it = it0 + 256 * j, cg_ = it & 63, rg = it >> 6;
            const bf16_t* ap = Am + (size_t)(MPR + 16 * rg + l16) * K + 8 * kq + wave * KSW * 32; const bf16_t* bp = Bm + (size_t)(16 * cg_ + l16) * K + 8 * kq + wave * KSW * 32;
            bf16x8 av[KSW], bv[KSW];
#pragma unroll
            for (int ks = 0; ks < KSW; ++ks) { av[ks] = *(const bf16x8*)(ap + 32 * ks); bv[ks] = *(const bf16x8*)(bp + 32 * ks); }
            acc[j] = (f32x4){0.f, 0.f, 0.f, 0.f};
#pragma unroll
            for (int ks = 0; ks < KSW; ++ks) acc[j] = __builtin_amdgcn_mfma_f32_16x16x32_bf16(av[ks], bv[ks], acc[j], 0, 0, 0); }
    }
    LAS f32x4* red = (LAS f32x4*)lds;
    red[(0 * 8 + wave) * 64 + lane] = acc[0]; red[(1 * 8 + wave) * 64 + lane] = acc[1];
    __syncthreads();
    if (wave < 2) { f32x4 s = red[(wave * 8) * 64 + lane];
#pragma unroll
        for (int w = 1; w < 8; ++w) s += red[(wave * 8 + w) * 64 + lane];
#pragma unroll
        for (int i = 0; i < 4; ++i) { const int sr = 16 * mrg + 4 * kq + i; float* op = A.out + (size_t)(MPR + sr) * 1024 + mcol; const float h = res[i] + s[i]; *op = h;
            if (IS_OUT) { ((bf16_t*)(ws + WS_HB))[(size_t)(MPR + sr) * 1024 + mcol] = (bf16_t)(pk2(h, 0.f) & 0xffffu);
                float q = h * h; q += __shfl_xor(q, 1); q += __shfl_xor(q, 2); q += __shfl_xor(q, 4); q += __shfl_xor(q, 8); if (l16 == 0) ((float*)(ws + WS_SSS))[sr * 64 + mcg] = q; } } }
    __syncthreads();
}
__device__ __forceinline__ void p8_fixup(ArgsRef A, int tid) {
    unsigned char* ws = A.ws; const float* SIDE = (const float*)(ws + WS_SIDE); bf16_t* ACT = (bf16_t*)(ws + WS_ACT); const float* wdw = A.in[28]; const float* bdw = A.in[29];
    const int gt = blockIdx.x * 512 + tid, NGT = gridDim.x * 512;
    for (int i = gt; i < 60 * 2 * 2816; i += NGT) { const int j = i % 2816, rr = (i / 2816) & 1, t60 = i / 5632; const int pm = (t60 / 15) * 16 + (t60 % 15) + 1;
        const int pg = 256 * (j >> 7) + (j & 127), pv = pg + 128; const float* s0 = SIDE + (size_t)((pm - 1) * 4) * 5632; const float* s1 = SIDE + (size_t)(pm * 4) * 5632;
        float g2, g1, g0, v2, v1, v0;
        if (rr == 0) { g2 = s0[2 * 5632 + pg]; g1 = s0[3 * 5632 + pg]; g0 = s1[pg]; v2 = s0[2 * 5632 + pv]; v1 = s0[3 * 5632 + pv]; v0 = s1[pv]; }
        else { g2 = s0[3 * 5632 + pg]; g1 = s1[pg]; g0 = s1[5632 + pg]; v2 = s0[3 * 5632 + pv]; v1 = s1[pv]; v0 = s1[5632 + pv]; }
        const float cg = wdw[j] * g2 + wdw[5632 + j] * g1 + wdw[2 * 5632 + j] * g0 + bdw[j];
        const float cv = wdw[2816 + j] * v2 + wdw[5632 + 2816 + j] * v1 + wdw[2 * 5632 + 2816 + j] * v0 + bdw[2816 + j];
        ACT[(size_t)(pm * 256 + rr) * 2816 + j] = (bf16_t)(pk2(cg * sigmoidf_(cg) * cv, 0.f) & 0xffffu); }
}
#define XB_TMO      128
#define XB_XCNT(j)  (256  + 64 * (j))
#define XB_XSUB(j)  (1280 + 64 * (j))
#define XB_XGEN(j)  (2304 + 64 * (j))
#define XB_TOP      3328
#define XB_TOPGEN   3392
#define XCD_BAR_WORDS 3456
#define XB_SPIN_CAP (1u << 18)

__device__ __forceinline__ unsigned xb_ld(unsigned* p)              { return __hip_atomic_load(p, __ATOMIC_RELAXED, __HIP_MEMORY_SCOPE_AGENT); }
__device__ __forceinline__ unsigned xb_add(unsigned* p, unsigned v) { return __hip_atomic_fetch_add(p, v, __ATOMIC_RELAXED, __HIP_MEMORY_SCOPE_AGENT); }
__device__ __forceinline__ unsigned xb_xcc_id() { return (unsigned)__builtin_amdgcn_s_getreg((3 << 11) | 20) & 0xFu; }
#define XB_SPIN(cond, bar) do { unsigned _sp = 0; while (cond) { __builtin_amdgcn_s_sleep(1); \
    if ((++_sp & 255u) == 0u) { if (xb_ld(&(bar)[XB_TMO])) break; if (_sp > XB_SPIN_CAP) { atomicAdd(&(bar)[XB_TMO], 1u); break; } } } } while (0)

struct XcdBarrier {
    unsigned* bar; unsigned x;
    volatile LAS unsigned* st;
};

__device__ __forceinline__ XcdBarrier xcd_barrier_post(unsigned* bar, volatile LAS unsigned* st) {
    XcdBarrier b; b.bar = bar; b.x = xb_xcc_id(); b.st = st;
    if (threadIdx.x == 0) (void)xb_add(&bar[XB_XCNT(b.x)], 1u);
    return b;
}
__device__ __forceinline__ void xcd_barrier_complete(unsigned* bar, unsigned x, unsigned& nloc, unsigned& nx) {
    const unsigned G = gridDim.x * gridDim.y * gridDim.z;
    unsigned sum, cnt, mine, sp = 0u;
    for (;;) {
        sum = 0u; cnt = 0u; mine = 0u;
#pragma unroll
        for (unsigned j = 0; j < 16; ++j) { const unsigned c = xb_ld(&bar[XB_XCNT(j)]); sum += c; cnt += (c > 0u) ? 1u : 0u; mine = (j == x) ? c : mine; }
        if (sum == G) break;
        __builtin_amdgcn_s_sleep(1);
        if ((++sp & 255u) == 0u) { if (xb_ld(&bar[XB_TMO])) break; if (sp > XB_SPIN_CAP) { atomicAdd(&bar[XB_TMO], 1u); break; } }
    }
    nloc = mine > 0u ? mine : 1u; nx = cnt > 0u ? cnt : 1u;
}

__device__ __forceinline__ void xcd_barrier(const XcdBarrier& b) {
    asm volatile("s_waitcnt vmcnt(0)" ::: "memory");
    __syncthreads();
    if (threadIdx.x == 0) {
        unsigned* bar = b.bar;
        __builtin_amdgcn_s_waitcnt(0);
        unsigned nloc = b.st[0], nx = b.st[1];
        if (nloc == 0u) { xcd_barrier_complete(bar, b.x, nloc, nx); b.st[0] = nloc; b.st[1] = nx; }
        const unsigned old = xb_add(&bar[XB_XSUB(b.x)], 1u);
        const unsigned gen = old / nloc;
        if (old + 1u == (gen + 1u) * nloc) {
            __builtin_amdgcn_fence(__ATOMIC_RELEASE, "agent");
            asm volatile("s_waitcnt vmcnt(0)" ::: "memory");
            const unsigned og = xb_add(&bar[XB_TOP], 1u);
            const unsigned tg = og / nx;
            if (og + 1u == (tg + 1u) * nx) xb_add(&bar[XB_TOPGEN], 1u);
            else XB_SPIN(xb_ld(&bar[XB_TOPGEN]) == tg, bar);
            __builtin_amdgcn_fence(__ATOMIC_ACQUIRE, "agent");
            xb_add(&bar[XB_XGEN(b.x)], 1u);
            asm volatile("s_waitcnt vmcnt(0)" ::: "memory");
        } else {
            XB_SPIN(xb_ld(&bar[XB_XGEN(b.x)]) == gen, bar);
            __builtin_amdgcn_fence(__ATOMIC_ACQUIRE, "agent");
            asm volatile("s_waitcnt vmcnt(0)" ::: "memory");
        }
    }
    __syncthreads();
}

#ifndef DUPMASK
#define DUPMASK 0
#endif
#ifndef PROBE_AV
#define PROBE_AV 0
#endif
#define REP(k) for (int rep_ = 0; rep_ < (((DUPMASK) >> (k)) & 1 ? 2 : 1); ++rep_)
__device__ __forceinline__ CArgs* args_opaque(CArgs* p) { asm volatile("" : "+s"(p)); return p; }
__global__ void __launch_bounds__(512, 2) fwd_kernel(Args A0) {
#define A (*args_opaque((CArgs*)__builtin_amdgcn_kernarg_segment_ptr()))
    extern __shared__ __attribute__((aligned(16))) unsigned char lds_raw[];
    LAS unsigned char* lds = (LAS unsigned char*)lds_raw;
    cg::grid_group grid = cg::this_grid();
    asm volatile("s_nop 0\n\ts_nop 0\n\ts_nop 0\n\ts_nop 0");
    if (threadIdx.x < 16) ((LAS unsigned*)(lds + LDS_QW))[threadIdx.x] = 0u;
    __syncthreads();
    XcdBarrier bar = xcd_barrier_post((unsigned*)(A.ws + WS_CTL) + 4096, (volatile LAS unsigned*)(lds + LDS_QW + 32));
    if (A.ws == nullptr) grid.sync();
#define GSYNC() xcd_barrier(bar)
    const int wave_s = __builtin_amdgcn_readfirstlane((int)threadIdx.x >> 6);
#define PHASE_IDS() const int wave = wave_s; int tid = lane_id_asm() + 64 * wave_s; asm volatile("" : "+v"(tid)); const int lane = tid & 63; (void)lane; (void)wave
    unsigned char* ws = A.ws; const int G = gridDim.x, bx = blockIdx.x;
#ifdef EXTRA_SYNCS
    for (int es_ = 0; es_ < EXTRA_SYNCS; ++es_) GSYNC();
#endif
    REP(0) { { PHASE_IDS(); p0_prologue(A, lds, tid, lane, wave); }
    GSYNC(); }
    REP(1) {if (bx >= 69) { PHASE_IDS(); p1_tables(A, tid, 69); __syncthreads(); idle_transposes(A, lds, lane, wave, 69, 0); __syncthreads(); }
    { pg8::Gemm g{(const bf16_t*)(ws + WS_XN), (const bf16_t*)(ws + WS_WIN), MP, NIN, 1024}; pg8::StaticOrder S; S.init(MP, NIN, G, bx); S.wave_s = wave_s;
      pg8::EpiBf16<0> E{(bf16_t*)(ws + WS_H1), NIN, nullptr, 0, 0, 1.f};
      pg8::gemm_phase<pg8::EpiBf16<0>, pg8::StaticOrder, true, true>(lds, g, S, E); }
    GSYNC(); }
    REP(2) { { PHASE_IDS(); p2_rows(A, lane, wave); }
    { PHASE_IDS(); p2_s5loc(A, lane, wave); }
    GSYNC(); }
    REP(3) {{ pg8::Gemm g{(const bf16_t*)(ws + WS_CKV), (const bf16_t*)(ws + WS_WKV), MKV, 1024, 256}; pg8::StaticOrder S; S.init(MKV, 1024, G, bx); S.wave_s = wave_s;
      EpiKV E{A};
      pg8::gemm_phase<EpiKV, pg8::StaticOrder, true, true>(lds, g, S, E); }
    { pg8::Gemm g{(const bf16_t*)(ws + WS_CQ), (const bf16_t*)(ws + WS_WQ), MP, 768, 384}; pg8::StaticOrder S; S.init(MP, 768, G, G - 1 - bx);     S.wave_s = wave_s;
      pg8::EpiBf16<0> E{(bf16_t*)(ws + WS_QRAW), 768, nullptr, 0, 0, 1.f};
      pg8::gemm_phase<pg8::EpiBf16<0>, pg8::StaticOrder, true, true>(lds, g, S, E); }
    GSYNC(); }
    REP(4) { { PHASE_IDS(); unsigned* ctr = (unsigned*)(ws + WS_CTL) + 512 * rep_; LAS int* qw = (LAS int*)(lds + LDS_QW); const int xcc = (int)(xb_xcc_id() & 7u);
#define Q_POP(dst) do { dst = -1; for (int k_ = 0; k_ < 8; ++k_) { const int qq_ = (xcc + k_) & 7; const unsigned v_ = atomicAdd(ctr + 64 * qq_, 1u); if (v_ < 108u) { dst = qq_ * 128 + (int)v_; break; } } } while (0)
      int nextcode = -1;
      if (tid == 0) { Q_POP(nextcode); *qw = nextcode; }
      for (;;) {
          __syncthreads();
          const int code = __builtin_amdgcn_readfirstlane(*qw);
          __syncthreads();
          if (code < 0) break;
          unsigned vown = 0xffffffffu; if (tid == 0) vown = atomicAdd(ctr + 64 * xcc, 1u);
          const int x = code >> 7, li = code & 127;
          int tid2 = tid; asm volatile("" : "+v"(tid2)); const int lane2 = tid2 & 63;
          const bool skip_s5 = ((DUPMASK) & 0x400) && rep_ == 1, skip_at = ((DUPMASK) & 0x800) && rep_ == 1;
          if (li < 32) { if (!skip_at) attn_unit((PROBE_AV != 0 && rep_ == 1) ? PROBE_AV : 0, A, false, x >> 1, 4 * (x & 1) + (li & 3), 15 - (li >> 2), lds, tid2, lane2, wave); }
          else if (li < 40) { if (!skip_at) attn_unit((PROBE_AV != 0 && rep_ == 1) ? PROBE_AV : 0, A, true, x, li - 32, 0, lds, tid2, lane2, wave); }
          else if (li < 44) { if (!skip_s5 && !(((DUPMASK) & 0x2000) && rep_ == 1)) s5s_item(A, 4 * x + (li - 40), lds, lane2, wave); }
          else { const int k = li - 44; if (k & 1) { if (!skip_s5) s5y_item(A, 32 * x + (k >> 1), lds, tid2, lane2, wave); } else if (!skip_at) attn_unit((PROBE_AV != 0 && rep_ == 1) ? PROBE_AV : 0, A, false, x >> 1, 4 * (x & 1) + ((k >> 1) & 3), 7 - (k >> 3), lds, tid2, lane2, wave); }
          if (tid == 0) { if (vown < 108u) nextcode = xcc * 128 + (int)vown; else Q_POP(nextcode); *qw = nextcode; }
      } }
#undef Q_POP
    GSYNC(); }
    REP(5) { if (bx >= 130) { PHASE_IDS(); idle_transposes(A, lds, lane, wave, 130, 1); }
    { pg8::Gemm g{(const bf16_t*)(ws + WS_G), (const bf16_t*)(ws + WS_WGLU), MP, 512, 512}; pg8::StaticOrder S; S.init(MP, 512, G, bx); S.wave_s = wave_s;
      EpiGLU E{A};
      pg8::gemm_phase<EpiGLU, pg8::StaticOrder, true, true>(lds, g, S, E); }
    GSYNC(); }
    REP(6) {{ pg8::Gemm g{(const bf16_t*)(ws + WS_MIX), (const bf16_t*)(ws + WS_WOUT), MPR, 1024, 1024}; pg8::StaticOrder S; S.init(MPR, 1024, G, bx); S.wave_s = wave_s;
      EpiOut E{A};
      pg8::gemm_phase<EpiOut, pg8::StaticOrder, true, true>(lds, g, S, E); }
    if (!(((DUPMASK) & 0x1000) && rep_ == 1)) { PHASE_IDS(); if (bx < 256) skinny_pair<4, true>(A, bx, lds, lane, wave); }
    GSYNC(); }
    REP(7) {{ pg8::Gemm g{(const bf16_t*)(ws + WS_HB), (const bf16_t*)(ws + WS_WUP), MP, 5632, 1024}; pg8::StaticOrder S; S.init(MP, 5632, G, bx); S.wave_s = wave_s;
      EpiUp E{A, (LAS float*)(lds + LDS_XCH)};
      pg8::gemm_phase<EpiUp, pg8::StaticOrder, true, true>(lds, g, S, E); }
    GSYNC(); }
    { PHASE_IDS(); p8_fixup(A, tid); }
    GSYNC();
    if ((DUPMASK) & 0x200) { pg8::Gemm g{(const bf16_t*)(ws + WS_ACT), (const bf16_t*)(ws + WS_WDN), MPR, 1024, 2816}; pg8::StaticOrder S; S.init(MPR, 1024, G, bx); S.wave_s = wave_s;
      EpiNull E{A}; pg8::gemm_phase<EpiNull, pg8::StaticOrder, true, true>(lds, g, S, E); GSYNC(); }
    { pg8::Gemm g{(const bf16_t*)(ws + WS_ACT), (const bf16_t*)(ws + WS_WDN), MPR, 1024, 2816}; pg8::StaticOrder S; S.init(MPR, 1024, G, bx); S.wave_s = wave_s;
      EpiDown E{A};
      pg8::gemm_phase<EpiDown, pg8::StaticOrder, true, true>(lds, g, S, E); }
    { PHASE_IDS(); if (bx < 256) skinny_pair<11, false>(A, bx, lds, lane, wave); }
}

#undef A
extern "C" void kernel_launch(void* const* d_in, const int* in_sizes, int n_in, void* d_out, int out_size, void* d_ws, size_t ws_size, hipStream_t stream) {
    static int grid = 0;
    if (grid == 0) {
        if (n_in != 31 || ws_size < WS_END) { fprintf(stderr, "kernel_launch: unexpected n_in %d / ws %zu\n", n_in, ws_size); grid = -1; return; }
        int dev = 0, cus = 0, per_cu = 0;
        hipGetDevice(&dev); hipDeviceGetAttribute(&cus, hipDeviceAttributeMultiprocessorCount, dev);
        hipFuncSetAttribute((const void*)fwd_kernel, hipFuncAttributeMaxDynamicSharedMemorySize, LDS_TOTAL);
        hipOccupancyMaxActiveBlocksPerMultiprocessor(&per_cu, (const void*)fwd_kernel, 512, LDS_TOTAL);
        (void)hipGetLastError();
        grid = cus > 0 ? cus : 256;
        if (per_cu < 1) fprintf(stderr, "kernel_launch: occupancy query says %d blocks/CU\n", per_cu);
    }
    if (grid < 0) return;
    if (hipMemsetAsync((char*)d_ws + WS_CTL, 0, 65536, stream) != hipSuccess) { fprintf(stderr, "kernel_launch: memset failed\n"); return; }
    Args a{};
    for (int i = 0; i < 31; ++i) a.in[i] = (const float*)d_in[i];
    a.out = (float*)d_out; a.ws = (unsigned char*)d_ws;
    void* args[] = {&a};
    hipError_t e = hipLaunchCooperativeKernel((const void*)fwd_kernel, dim3(grid), dim3(512), args, LDS_TOTAL, stream);
    if (e != hipSuccess) fprintf(stderr, "cooperative launch failed: %s (grid %d)\n", hipGetErrorString(e), grid);
}
```

```cpp
#include <hip/hip_runtime.h>
#include <hip/hip_cooperative_groups.h>
#include <cstdio>
#include <cstdint>
namespace cg = cooperative_groups;
__device__ __forceinline__ int lane_id_asm() { int l; asm volatile("v_mbcnt_lo_u32_b32 %0, -1, 0\n\tv_mbcnt_hi_u32_b32 %0, -1, %0" : "=v"(l)); return l; }
namespace pg8 {
#define PG8_LAS __attribute__((address_space(3)))
typedef unsigned short bf16_t;
typedef short bf16x8 __attribute__((ext_vector_type(8)));
typedef float f32x4 __attribute__((ext_vector_type(4)));
typedef unsigned u32x4 __attribute__((ext_vector_type(4)));
constexpr int BM = 256, BK = 64, HALF = 128, HTB = HALF * BK * 2  , STAGE_BYTES = 8 * HTB, NXCD = 8, WGM = 8;

__host__ __device__ __forceinline__ int lds_byte(int r, int c) { const int st = (r >> 4) * 2 + (c >> 5), rr = r & 15, cc = c & 31, ob = rr * 64 + cc * 2; return st * 1024 + (ob ^ (((ob >> 9) & 1) << 5)); }
__host__ __device__ __forceinline__ void stage_rc(int b, int& R, int& C) { const int st = b / 1024, sb = b % 1024, swz = sb ^ (((sb >> 9) & 1) << 5); R = (st >> 1) * 16 + swz / 64; C = (st & 1) * 32 + (swz % 64) / 2; }
__host__ __device__ __forceinline__ int perm32(int rho) { const int n = rho >> 4, i = rho & 15; return 8 * (i >> 2) + 4 * n + (i & 3); }

struct Unit { int pm, pn; };
struct Gemm { const bf16_t* A; const bf16_t* Bt; int M, N, K; };

struct StaticOrder {
    int nM, nN, nwg, G, c, wave_s;
    __host__ __device__ void init(int M, int N, int G_, int c_) { nM = M / BM; nN = N / BM; nwg = nM * nN; G = G_; c = c_; }
    __host__ __device__ bool next(int i, Unit& u) const {
        const long L = (long)i * G + c; if (L >= nwg) return false;
        int wgid = (int)L; { const int q = nwg / NXCD, r = nwg % NXCD, xcd = wgid % NXCD, off = wgid / NXCD; wgid = (xcd < r ? xcd * (q + 1) : r * (q + 1) + (xcd - r) * q) + off; }
        const int nig = WGM * nN, gid = wgid / nig, fm = gid * WGM, gsz = (nM - fm) < WGM ? (nM - fm) : WGM;
        u.pm = fm + ((wgid % nig) % gsz); u.pn = (wgid % nig) / gsz; return true;
    }
    __device__ __forceinline__ void a_ready(const Unit&) const {}
    __device__ __forceinline__ void done(const Unit&) const {}
};

__device__ __forceinline__ unsigned cvt_pk_bf16(float lo, float hi) { unsigned r; asm volatile("v_cvt_pk_bf16_f32 %0, %1, %2" : "=v"(r) : "v"(lo), "v"(hi)); return r; }
typedef float f32x2 __attribute__((ext_vector_type(2)));
__device__ __forceinline__ f32x2 gelu_pk(f32x2 v) {
    const f32x2 av = __builtin_elementwise_abs(v), d = av * 0.2316418882f + 1.0f;
    f32x2 t; t.x = __builtin_amdgcn_rcpf(d.x); t.y = __builtin_amdgcn_rcpf(d.y);
    f32x2 q = t * 0.5307027145f + (-0.7265760135f); q = q * t + 0.7107068705f; q = q * t + (-0.142248368f); q = q * t + 0.127414796f; q = q * t;
    const f32x2 s = (v * v) * (-0.72134752044f);
    f32x2 e; e.x = __builtin_amdgcn_exp2f(s.x); e.y = __builtin_amdgcn_exp2f(s.y);
    const f32x2 m = v * (q * e), r = v - m;
    f32x2 o; o.x = v.x < 0.f ? m.x : r.x; o.y = v.y < 0.f ? m.y : r.y; return o;
}

template <int ACT  > struct EpiBf16 {
    static constexpr bool PERM = true, AFTER_DRAIN = false; static_assert(ACT == 0 || ACT == 1, "EpiBf16: ACT is 0 (none) or 1 (gelu_pk)");
    bf16_t* O; int ldc; const float* bias; int split_cols; size_t split_stride; float scale0;
    __device__ __forceinline__ void operator()(const f32x4 (&acc)[2][2][4][2], const Unit& u, int wr, int wc, int fr, int fq) const {
        const int row0 = u.pm * BM + wr * 64 + fr; int colt = u.pn * BM; bf16_t* base = O;
        float sc = 1.f; if (split_cols) { const int t = colt / split_cols; base += (size_t)t * split_stride; colt -= t * split_cols; if (t == 0) sc = scale0; }
        const int col0 = colt + wc * 32 + 8 * fq, bcol0 = u.pn * BM + wc * 32 + 8 * fq;
        f32x4 bv[2][2];
#pragma unroll
        for (int bj = 0; bj < 2; ++bj)
#pragma unroll
            for (int n = 0; n < 2; ++n) bv[bj][n] = bias ? *(const f32x4*)(bias + bcol0 + bj * HALF + 4 * n) : (f32x4){0.f, 0.f, 0.f, 0.f};
#pragma unroll
        for (int ai = 0; ai < 2; ++ai)
#pragma unroll
            for (int m = 0; m < 4; ++m) { bf16_t* rowp = base + (size_t)(row0 + ai * HALF + m * 16) * ldc + col0;
#pragma unroll
                for (int bj = 0; bj < 2; ++bj) { f32x4 v0 = acc[ai][bj][m][0] + bv[bj][0], v1 = acc[ai][bj][m][1] + bv[bj][1];
                    if (ACT == 1) { f32x2 a = gelu_pk((f32x2){v0[0], v0[1]}), b = gelu_pk((f32x2){v0[2], v0[3]}), c = gelu_pk((f32x2){v1[0], v1[1]}), d = gelu_pk((f32x2){v1[2], v1[3]});
                        v0 = (f32x4){a.x, a.y, b.x, b.y}; v1 = (f32x4){c.x, c.y, d.x, d.y}; }
                    v0 = v0 * sc; v1 = v1 * sc; u32x4 w; w.x = cvt_pk_bf16(v0[0], v0[1]); w.y = cvt_pk_bf16(v0[2], v0[3]); w.z = cvt_pk_bf16(v1[0], v1[1]); w.w = cvt_pk_bf16(v1[2], v1[3]);
                    *(u32x4*)(rowp + bj * HALF) = w; } }
    }
};
template <class Epi, class Sched, bool ALIGN_EPI = false, bool SP2 = false>
__device__ __forceinline__ void gemm_phase(PG8_LAS unsigned char* lds, const Gemm g, const Sched& S, const Epi& E) {
    int tid_ = lane_id_asm() + 64 * S.wave_s; asm volatile("" : "+v"(tid_));
    const int tid = tid_, wid = __builtin_amdgcn_readfirstlane(tid >> 6), lane = tid & 63, wr = wid >> 2, wc = wid & 3, fr = lane & 15, fq = lane >> 4;
    const int K = g.K, nt = K / BK;
    unsigned voffA[2], voffB[2];
#pragma unroll
    for (int i = 0; i < 2; ++i) { int R, C; stage_rc(tid * 16 + i * 8192, R, C); const int Rb = Epi::PERM ? ((R & ~31) + perm32(R & 31)) : R;
        voffA[i] = (unsigned)(R * K + C) * 2u; voffB[i] = (unsigned)(Rb * K + C) * 2u; }
    const size_t kstep = (size_t)(BK * 2);
    const size_t hstep = (size_t)HALF * K * 2;
    const size_t tstep = 2 * hstep;
    const unsigned ldsw = (unsigned)wid * 1024u;
    const int aoff = lds_byte(wr * 64 + fr, fq * 8), boff = lds_byte(wc * 32 + fr, fq * 8);
#define PG8_SA(b, h) (((b) * 2 + (h)) * HTB)
#define PG8_SB(b, h) ((4 + (b) * 2 + (h)) * HTB)
#define PG8_STAGE(bufoff, gbase, voff) do { _Pragma("unroll") for (int _i = 0; _i < 2; ++_i) \
        __builtin_amdgcn_global_load_lds((const unsigned*)((const char*)(gbase) + (voff)[_i]), (PG8_LAS unsigned*)(lds + (bufoff) + ldsw + _i * 8192), 16, 0, 0); } while (0)
#define PG8_LDA(dst, b, h) do { _Pragma("unroll") for (int m = 0; m < 4; ++m) _Pragma("unroll") for (int k = 0; k < 2; ++k) dst[m][k] = *(const PG8_LAS bf16x8*)(lds + PG8_SA(b, h) + aoff + m * 2048 + k * 1024); } while (0)
#define PG8_LDB(dst, b, h) do { _Pragma("unroll") for (int n = 0; n < 2; ++n) _Pragma("unroll") for (int k = 0; k < 2; ++k) dst[n][k] = *(const PG8_LAS bf16x8*)(lds + PG8_SB(b, h) + boff + n * 2048 + k * 1024); } while (0)
#define PG8_MMA(ai, bj, At, Bt) do { __builtin_amdgcn_s_setprio(1); _Pragma("unroll") for (int m = 0; m < 4; ++m) _Pragma("unroll") for (int n = 0; n < 2; ++n) _Pragma("unroll") for (int k = 0; k < 2; ++k) \
        acc[ai][bj][m][n] = __builtin_amdgcn_mfma_f32_16x16x32_bf16(Bt[n][k], At[m][k], acc[ai][bj][m][n], 0, 0, 0); __builtin_amdgcn_s_setprio(0); } while (0)
#define PG8_WAIT_V(n) asm volatile("s_waitcnt vmcnt(" #n ")" ::: "memory")
#define PG8_WAIT_L(n) asm volatile("s_waitcnt lgkmcnt(" #n ")" ::: "memory")
#define PG8_BAR __builtin_amdgcn_s_barrier()
#define PG8_SCHED __builtin_amdgcn_sched_barrier(0)
    Unit cur, nxt; int ui = 0;
    if (!S.next(0, cur)) return;
    f32x4 acc[2][2][4][2];
#pragma unroll
    for (int a = 0; a < 2; ++a)
#pragma unroll
        for (int b = 0; b < 2; ++b)
#pragma unroll
            for (int m = 0; m < 4; ++m)
#pragma unroll
                for (int n = 0; n < 2; ++n) acc[a][b][m][n] = (f32x4){0.f, 0.f, 0.f, 0.f};
    bf16x8 At[4][2], B0[2][2], B1[2][2];
    const char* cA = (const char*)g.A + (size_t)cur.pm * tstep; const char* cB = (const char*)g.Bt + (size_t)cur.pn * tstep;
    S.a_ready(cur);
    if constexpr (SP2) {
        PG8_STAGE(PG8_SB(0, 0), cB, voffB); PG8_STAGE(PG8_SB(0, 1), cB + hstep, voffB); PG8_STAGE(PG8_SA(0, 0), cA, voffA); PG8_STAGE(PG8_SA(0, 1), cA + hstep, voffA);
        if (wr == 1) PG8_BAR;
        PG8_WAIT_V(2); PG8_BAR;
        PG8_STAGE(PG8_SB(1, 0), cB + kstep, voffB); PG8_STAGE(PG8_SA(1, 0), cA + kstep, voffA); PG8_STAGE(PG8_SB(1, 1), cB + hstep + kstep, voffB);
        PG8_WAIT_V(6); PG8_BAR;
    } else {
        PG8_STAGE(PG8_SB(0, 0), cB, voffB); PG8_STAGE(PG8_SA(0, 0), cA, voffA); PG8_STAGE(PG8_SB(0, 1), cB + hstep, voffB); PG8_STAGE(PG8_SA(0, 1), cA + hstep, voffA);
        if (wr == 1) PG8_BAR;
        PG8_WAIT_V(4); PG8_BAR;
        PG8_STAGE(PG8_SB(1, 0), cB + kstep, voffB); PG8_STAGE(PG8_SA(1, 0), cA + kstep, voffA); PG8_STAGE(PG8_SB(1, 1), cB + hstep + kstep, voffB);
        PG8_WAIT_V(6); PG8_BAR;
    }
    for (;;) {
        const bool has_next = S.next(ui + 1, nxt);
        const char* nA = has_next ? (const char*)g.A + (size_t)nxt.pm * tstep : cA; const char* nB = has_next ? (const char*)g.Bt + (size_t)nxt.pn * tstep : cB;
        for (int t = 0; t < nt; t += 2) {
            const bool last = (t == nt - 2);
            const char* a1 = cA + (size_t)(t + 1) * kstep;
            const char* a2 = last ? nA : cA + (size_t)(t + 2) * kstep; const char* b2 = last ? nB : cB + (size_t)(t + 2) * kstep;
            const char* a3 = a2 + kstep; const char* b3 = b2 + kstep;
            if (last && has_next) S.a_ready(nxt);
            if constexpr (SP2) {
            PG8_LDB(B0, 0, 0); PG8_LDB(B1, 0, 1); PG8_SCHED; PG8_LDA(At, 0, 0); PG8_STAGE(PG8_SA(1, 1), a1 + hstep, voffA);
            PG8_WAIT_V(8); PG8_WAIT_L(0); PG8_BAR; PG8_MMA(0, 0, At, B0); PG8_MMA(0, 1, At, B1); PG8_BAR; PG8_SCHED;
            PG8_LDA(At, 0, 1); PG8_STAGE(PG8_SB(0, 0), b2, voffB); PG8_STAGE(PG8_SB(0, 1), b2 + hstep, voffB); PG8_STAGE(PG8_SA(0, 0), a2, voffA);
            PG8_WAIT_V(8); PG8_WAIT_L(0); PG8_BAR; PG8_MMA(1, 0, At, B0); PG8_MMA(1, 1, At, B1); PG8_BAR; PG8_SCHED;
            PG8_LDB(B0, 1, 0); PG8_LDB(B1, 1, 1); PG8_SCHED; PG8_LDA(At, 1, 0); PG8_STAGE(PG8_SA(0, 1), a2 + hstep, voffA);
            PG8_WAIT_V(8); PG8_WAIT_L(0); PG8_BAR; PG8_MMA(0, 0, At, B0); PG8_MMA(0, 1, At, B1); PG8_BAR; PG8_SCHED;
            PG8_LDA(At, 1, 1); PG8_STAGE(PG8_SB(1, 0), b3, voffB); PG8_STAGE(PG8_SB(1, 1), b3 + hstep, voffB); PG8_STAGE(PG8_SA(1, 0), a3, voffA);
            PG8_WAIT_V(8); PG8_WAIT_L(0); PG8_BAR; PG8_MMA(1, 0, At, B0); PG8_MMA(1, 1, At, B1); PG8_BAR; PG8_SCHED;
            } else {
            PG8_LDB(B0, 0, 0); PG8_SCHED; PG8_LDA(At, 0, 0); PG8_STAGE(PG8_SA(1, 1), a1 + hstep, voffA);
            PG8_WAIT_L(8); PG8_BAR; PG8_WAIT_L(0); PG8_MMA(0, 0, At, B0); PG8_BAR; PG8_SCHED;
            PG8_LDB(B1, 0, 1); PG8_STAGE(PG8_SB(0, 0), b2, voffB);
            PG8_BAR; PG8_WAIT_L(0); PG8_MMA(0, 1, At, B1); PG8_BAR;
            PG8_LDA(At, 0, 1); PG8_STAGE(PG8_SA(0, 0), a2, voffA);
            PG8_BAR; PG8_WAIT_L(0); PG8_MMA(1, 0, At, B0); PG8_BAR; PG8_SCHED;
            PG8_STAGE(PG8_SB(0, 1), b2 + hstep, voffB);
            PG8_WAIT_V(6); PG8_BAR; PG8_MMA(1, 1, At, B1); PG8_BAR;
            PG8_LDB(B0, 1, 0); PG8_SCHED; PG8_LDA(At, 1, 0); PG8_STAGE(PG8_SA(0, 1), a2 + hstep, voffA);
            PG8_WAIT_L(8); PG8_BAR; PG8_WAIT_L(0); PG8_MMA(0, 0, At, B0); PG8_BAR; PG8_SCHED;
            PG8_LDB(B1, 1, 1); PG8_STAGE(PG8_SB(1, 0), b3, voffB);
            PG8_BAR; PG8_WAIT_L(0); PG8_MMA(0, 1, At, B1); PG8_BAR;
            PG8_LDA(At, 1, 1); PG8_STAGE(PG8_SA(1, 0), a3, voffA);
            PG8_BAR; PG8_WAIT_L(0); PG8_MMA(1, 0, At, B0); PG8_BAR; PG8_SCHED;
            PG8_STAGE(PG8_SB(1, 1), b3 + hstep, voffB);
            PG8_WAIT_V(6); PG8_BAR; PG8_MMA(1, 1, At, B1); PG8_BAR;
            }
        }
        if constexpr (ALIGN_EPI) { if (wr == 0) PG8_BAR; }
        if constexpr (!Epi::AFTER_DRAIN) { int fr_ = fr, fq_ = fq; asm volatile("" : "+v"(fr_), "+v"(fq_)); E(acc, cur, wr, wc, fr_, fq_); S.done(cur); }
        if (!has_next) break;
#pragma unroll
        for (int a = 0; a < 2; ++a)
#pragma unroll
            for (int b = 0; b < 2; ++b)
#pragma unroll
                for (int m = 0; m < 4; ++m)
#pragma unroll
                    for (int n = 0; n < 2; ++n) acc[a][b][m][n] = (f32x4){0.f, 0.f, 0.f, 0.f};
        cur = nxt; cA = nA; cB = nB; ++ui;
        if constexpr (ALIGN_EPI) { if (wr == 1) PG8_BAR; }
    }
    PG8_WAIT_V(0);
    if constexpr (!ALIGN_EPI) { if (wr == 0) PG8_BAR; }
    PG8_BAR;
    if constexpr (Epi::AFTER_DRAIN) { E.fused(acc, cur, wr, wc, fr, fq, lds, wid, lane); S.done(cur); }
#undef PG8_SA
#undef PG8_SB
#undef PG8_STAGE
#undef PG8_LDA
#undef PG8_LDB
#undef PG8_MMA
#undef PG8_WAIT_V
#undef PG8_WAIT_L
#undef PG8_BAR
#undef PG8_SCHED
}
}
#define LAS __attribute__((address_space(3)))
typedef unsigned short bf16_t;
typedef short bf16x8 __attribute__((ext_vector_type(8)));
typedef short s16x4 __attribute__((ext_vector_type(4)));
typedef float f32x4 __attribute__((ext_vector_type(4)));
typedef float f32x16 __attribute__((ext_vector_type(16)));
typedef unsigned u32x4 __attribute__((ext_vector_type(4)));
typedef unsigned u32x2 __attribute__((ext_vector_type(2)));

constexpr int MPR = 16384, MV = 16512, MP = 16640, MKV = 33280, SKVB = 2112, NIN = 1280;
constexpr float EPSF = 1e-6f;
constexpr size_t KiB = 1024;
constexpr size_t WS_CTL = 0, WS_WIN = 1024 * KiB, WS_WQ = 3584 * KiB, WS_WKV = 4352 * KiB, WS_WGLU = 4864 * KiB, WS_WOUT = 5376 * KiB, WS_WUP = 7424 * KiB, WS_WDN = 18688 * KiB;
constexpr size_t WS_ROPE = 24576 * KiB, WS_POW = 25088 * KiB, WS_KP = 26624 * KiB, WS_FT = 28672 * KiB, WS_ET = 36864 * KiB, WS_BB = 45056 * KiB, WS_SLOC = 46080 * KiB, WS_KROT = 50176 * KiB, WS_ROTSS = 54336 * KiB;
constexpr size_t WS_H1 = 55296 * KiB, WS_HB = WS_H1, WS_XN = 97280 * KiB, WS_QRAW = WS_XN, WS_SS = WS_XN, WS_SSS = 98432 * KiB, WS_SIDE = 98816 * KiB;
constexpr size_t WS_CQ = 131072 * KiB, WS_G = WS_CQ, WS_CKV = 143872 * KiB, WS_MIX = 160768 * KiB, WS_ACT = WS_MIX, WS_KB = 194560 * KiB, WS_END = 252288 * KiB;
constexpr size_t O_YP = 0, O_YS = 16777216, O_KVP = 16908288, O_KRP = 21102592, O_S5RP = 21626880, O_S5IP = 21635072, O_CONVP = 21643264,
                 O_KVS = 21688320, O_KRS = 21721088, O_S5RS = 21725184, O_S5IS = 21741568, O_CONVS = 21757952;
constexpr int LDS_RING = 131072, LDS_XCH = 131072, LDS_QW = 131072 + 8192, LDS_TOTAL = 147456;

struct Args { const float* in[31]; float* out; unsigned char* ws; };
typedef const __attribute__((address_space(4))) Args CArgs;
typedef CArgs& ArgsRef;

typedef float f32x2_t __attribute__((ext_vector_type(2))); typedef __bf16 bf16x2_t __attribute__((ext_vector_type(2)));
__device__ __forceinline__ unsigned pk2(float lo, float hi) { f32x2_t v = {lo, hi}; bf16x2_t b = __builtin_convertvector(v, bf16x2_t); return __builtin_bit_cast(unsigned, b); }
__device__ __forceinline__ float bflo(unsigned w) { return __uint_as_float(w << 16); }
__device__ __forceinline__ float bfhi(unsigned w) { return __uint_as_float(w & 0xffff0000u); }
__device__ __forceinline__ float wave_sum(float v) {
#pragma unroll
    for (int o = 1; o < 64; o <<= 1) v += __shfl_xor(v, o);
    return v;
}
#define LDS_WAIT() asm volatile("s_waitcnt lgkmcnt(0)" ::: "memory")
__device__ __forceinline__ float gelu_tanh(float y) {
    const float z = 0.7978845608028654f * (y + 0.044715f * y * y * y);
    const float e = __builtin_amdgcn_exp2f(2.885390081777927f * z);
    const float t = 1.f - 2.f * __builtin_amdgcn_rcpf(e + 1.f);
    return 0.5f * y * (1.f + t);
}
__device__ __forceinline__ float sigmoidf_(float z) { return __builtin_amdgcn_rcpf(1.f + __builtin_amdgcn_exp2f(-1.4426950408889634f * z)); }

__device__ __forceinline__ int rowmap(int mode, int n) {
    if (mode == 1) return n < 640 ? n : (n < 672 ? n + 512 : n - 32);
    if (mode == 2) { const int h = n >> 7, j = n & 127, isv = j >> 6, d = j & 63; return 256 * (2 * isv + (h >> 2)) + 128 * (d >> 5) + 32 * (h & 3) + (d & 31); }
    if (mode == 3) { const int isv = n >= 2816 ? 1 : 0; const int j = isv ? n - 2816 : n; return 256 * (j >> 7) + 128 * isv + (j & 127); }
    return n;
}
__device__ __forceinline__ void tr_item(const float* W, int K, int N, bf16_t* WT, LAS float* scr, int item, int lane, int mode, const float* ksc) {
    const int nblk = N / 32, kb = item / nblk, nb = item % nblk, k0 = 64 * kb, n0 = 32 * nb;
#pragma unroll 8
    for (int i = 0; i < 32; ++i) { const int kk = 2 * i + (lane >> 5); float v = W[(size_t)(k0 + kk) * N + n0 + (lane & 31)]; if (ksc) v *= ksc[k0 + kk]; scr[kk * 33 + (lane & 31)] = v; }
    LDS_WAIT();
    const int c = lane & 7;
#pragma unroll
    for (int j = 0; j < 4; ++j) { const int n = (lane >> 3) + 8 * j; const LAS float* s = scr + (8 * c) * 33 + n;
        u32x4 o; o.x = pk2(s[0 * 33], s[1 * 33]); o.y = pk2(s[2 * 33], s[3 * 33]); o.z = pk2(s[4 * 33], s[5 * 33]); o.w = pk2(s[6 * 33], s[7 * 33]);
        *(u32x4*)(WT + (size_t)rowmap(mode, n0 + n) * K + k0 + 8 * c) = o; }
    LDS_WAIT();
}
__device__ __forceinline__ void s5_lambda(ArgsRef A, int g, int p, int j, float& pr, float& pi) {
    const float dt = expf(A.in[17][g]); const float are = A.in[15][g * 64 + p], aim = A.in[16][g * 64 + p];
    const double e = (double)are * (double)dt * (double)j; double th = (double)aim * (double)dt * (double)j;
    th -= 6.283185307179586 * rint(th * 0.15915494309189535);
    const float mag = expf((float)e), r = (float)th;
    pr = mag * cosf(r); pi = mag * sinf(r);
}
__device__ __forceinline__ void p0_prologue(ArgsRef A, LAS unsigned char* lds, int tid, int lane, int wave) {
    unsigned char* ws = A.ws;
    const int G = gridDim.x, gw = blockIdx.x * 8 + wave, NGW = G * 8, gt = blockIdx.x * 512 + tid, NGT = G * 512;
    LAS float* scr = (LAS float*)(lds + wave * 16384);
    constexpr int I0 = 16 * 37, I1 = 6 * 24, I2 = 4 * 32, I3 = 8 * 16, NIT = I0 + I1 + I2 + I3;
    for (int it = gw; it < NIT; it += NGW) {
        int r = it;
        if (r < I0) { tr_item(A.in[8], 1024, 1184, (bf16_t*)(ws + WS_WIN), scr, r, lane, 1, nullptr); continue; } r -= I0;
        if (r < I1) { tr_item(A.in[10], 384, 768, (bf16_t*)(ws + WS_WQ), scr, r, lane, 0, nullptr); continue; } r -= I1;
        if (r < I2) { tr_item(A.in[12], 256, 1024, (bf16_t*)(ws + WS_WKV), scr, r, lane, 2, nullptr); continue; } r -= I2;
        tr_item(A.in[23], 512, 512, (bf16_t*)(ws + WS_WGLU), scr, r, lane, 0, nullptr);
    }
    for (int r = gw; r < 96; r += NGW) { u32x4* d = (u32x4*)((bf16_t*)(ws + WS_WIN) + (size_t)(1184 + r) * 1024); d[lane] = (u32x4){0, 0, 0, 0}; d[64 + lane] = (u32x4){0, 0, 0, 0}; }
    { const f32x4* gm = (const f32x4*)A.in[7]; bf16_t* XN = (bf16_t*)(ws + WS_XN);
      for (int r = gw; r < MV; r += 2 * NGW) {
        f32x4 v[2][4];
#pragma unroll
        for (int u = 0; u < 2; ++u) { const int rr = r + u * NGW; if (rr < MV) { const f32x4* xr = (const f32x4*)(rr < MPR ? A.in[0] + (size_t)rr * 1024 : A.in[1] + (size_t)(rr - MPR) * 1024);
#pragma unroll
            for (int j = 0; j < 4; ++j) v[u][j] = xr[lane + 64 * j]; } }
#pragma unroll
        for (int u = 0; u < 2; ++u) { const int rr = r + u * NGW; if (rr < MV) { float ss = 0.f;
#pragma unroll
            for (int j = 0; j < 4; ++j) ss += (v[u][j].x * v[u][j].x + v[u][j].y * v[u][j].y) + (v[u][j].z * v[u][j].z + v[u][j].w * v[u][j].w);
            const float rs = rsqrtf(wave_sum(ss) * (1.f / 1024.f) + EPSF);
            u32x2* o = (u32x2*)(XN + (size_t)rr * 1024);
#pragma unroll
            for (int j = 0; j < 4; ++j) { const f32x4 gg = gm[lane + 64 * j]; u32x2 w; w.x = pk2(v[u][j].x * rs * gg.x, v[u][j].y * rs * gg.y); w.y = pk2(v[u][j].z * rs * gg.z, v[u][j].w * rs * gg.w); o[lane + 64 * j] = w; } } }
      } }
    { bf16_t* CKV = (bf16_t*)(ws + WS_CKV);
      for (int i0 = gw; i0 < 16384; i0 += 4 * NGW) { f32x4 v[4];
#pragma unroll
        for (int u = 0; u < 4; ++u) { const int i = i0 + u * NGW; if (i < 16384) v[u] = ((const f32x4*)(A.in[2] + (size_t)i * 256))[lane]; }
#pragma unroll
        for (int u = 0; u < 4; ++u) { const int i = i0 + u * NGW; if (i < 16384) { const int b = i >> 11, t = i & 2047; u32x2 w; w.x = pk2(v[u].x, v[u].y); w.y = pk2(v[u].z, v[u].w); ((u32x2*)(CKV + (size_t)(16384 + b * SKVB + t) * 256))[lane] = w; } } }
      float* KROT = (float*)(ws + WS_KROT); float* ROTSS = (float*)(ws + WS_ROTSS);
      for (int i = gw; i < 8 * 48; i += NGW) { const int b = i / 48, j = i % 48; const size_t kr = (size_t)(16384 + b * SKVB + 2064 + j);
        ((u32x2*)(CKV + kr * 256))[lane] = (u32x2){0, 0}; if (lane < 32) KROT[kr * 32 + lane] = 0.f; if (lane == 0) ROTSS[kr] = 0.f; }
      for (int i = gt; i < 16384; i += NGT) { const int b = i >> 11, t = i & 2047; const size_t kr = (size_t)(16384 + b * SKVB + t); const f32x4* s = (const f32x4*)(A.in[3] + (size_t)i * 32); f32x4* d = (f32x4*)(KROT + kr * 32); float ss = 0.f;
#pragma unroll
        for (int j = 0; j < 8; ++j) { const f32x4 v = s[j]; d[j] = v; ss += (v.x * v.x + v.y * v.y) + (v.z * v.z + v.w * v.w); }
        ROTSS[kr] = ss; } }
    { float* RP = (float*)(ws + WS_ROPE);
      for (int i = gt; i < 4096 * 16; i += NGT) { const int pos = i >> 4, k = i & 15; const float inv = powf(10000.f, -(float)(2 * k) / 32.f); const float ang = (float)pos * inv;
        RP[pos * 32 + k] = cosf(ang); RP[pos * 32 + 16 + k] = sinf(ang); } }
    { float* PW = (float*)(ws + WS_POW);
      for (int i = gt; i < 32 * 65 * 64; i += NGT) { const int p = i & 63, j = (i >> 6) % 65, g = i / (65 * 64); float pr, pi; s5_lambda(A, g, p, j, pr, pi); PW[2 * i] = pr; PW[2 * i + 1] = pi; } }
    { float* BB = (float*)(ws + WS_BB);
      for (int i = gt; i < 32 * 64; i += NGT) { const int p = i & 63, g = i >> 6; float lr, li; s5_lambda(A, g, p, 1, lr, li);
        const double are = A.in[15][i], aim = A.in[16][i]; const double nr = (double)lr - 1.0, ni = li, den = are * are + aim * aim;
        const float fr = (float)((nr * are + ni * aim) / den), fi = (float)((ni * are - nr * aim) / den);
#pragma unroll
        for (int c = 0; c < 16; ++c) { const float br = A.in[18][i * 16 + c], bi = A.in[19][i * 16 + c]; BB[(i * 16 + c) * 2] = fr * br - fi * bi; BB[(i * 16 + c) * 2 + 1] = fr * bi + fi * br; } } }
}

__device__ __forceinline__ void idle_transposes(ArgsRef A, LAS unsigned char* lds, int lane, int wave, int first_block, int which) {
    unsigned char* ws = A.ws; const int gw = ((int)blockIdx.x - first_block) * 8 + wave, NGW = ((int)gridDim.x - first_block) * 8;
    LAS float* scr = (LAS float*)(lds + wave * 16384);
    constexpr int I4 = 16 * 32, I5 = 16 * 176, I6 = 44 * 32;
    if (which == 0) {
        for (int it = gw; it < I4 + I6; it += NGW) {
            if (it < I4) tr_item(A.in[25], 1024, 1024, (bf16_t*)(ws + WS_WOUT), scr, it, lane, 0, nullptr);
            else tr_item(A.in[30], 2816, 1024, (bf16_t*)(ws + WS_WDN), scr, it - I4, lane, 0, nullptr);
        }
    } else {
        for (int it = gw; it < I5; it += NGW) tr_item(A.in[27], 1024, 5632, (bf16_t*)(ws + WS_WUP), scr, it, lane, 3, A.in[26]);
    }
}
__device__ __forceinline__ void p1_tables(ArgsRef A, int tid, int first_block) {
    unsigned char* ws = A.ws; const int gt = ((int)blockIdx.x - first_block) * 512 + tid, NGT = ((int)gridDim.x - first_block) * 512;
    const float* PW = (const float*)(ws + WS_POW); const float* BB = (const float*)(ws + WS_BB); const float* Cre = A.in[20]; const float* Cim = A.in[21];
    { bf16_t* KP = (bf16_t*)(ws + WS_KP);
      for (int i = gt; i < 32 * 64 * 64; i += NGT) { const int ln = i & 63, j = (i >> 6) & 63, g = i >> 12; const int c = ln & 15, kq = ln >> 4, jj = j - (kq >> 1), c0 = 8 * (kq & 1);
        float acc[8];
#pragma unroll
        for (int k = 0; k < 8; ++k) acc[k] = 0.f;
        if (jj >= 0) { const float* pw = PW + (size_t)((g * 65 + jj) * 64) * 2; const float* cr = Cre + (g * 16 + c) * 64; const float* ci = Cim + (g * 16 + c) * 64; const float* bb = BB + (size_t)(g * 64) * 32 + c0 * 2;
#pragma unroll 4
            for (int p = 0; p < 64; ++p) { const float xr = cr[p] * pw[2 * p] - ci[p] * pw[2 * p + 1], xi = cr[p] * pw[2 * p + 1] + ci[p] * pw[2 * p]; const f32x4* b4 = (const f32x4*)(bb + p * 32);
#pragma unroll
                for (int k = 0; k < 4; ++k) { const f32x4 q = b4[k]; acc[2 * k] += xr * q.x - xi * q.y; acc[2 * k + 1] += xr * q.z - xi * q.w; } } }
        u32x4 o; o.x = pk2(acc[0], acc[1]); o.y = pk2(acc[2], acc[3]); o.z = pk2(acc[4], acc[5]); o.w = pk2(acc[6], acc[7]);
        *(u32x4*)(KP + (size_t)i * 8) = o; } }
    { bf16_t* FT = (bf16_t*)(ws + WS_FT);
      for (int i0 = gt; i0 < 32 * 64 * 4 * 64; i0 += 4 * NGT) { f32x4 pw4[4][4], cr4[4][2], ci4[4][2];
#pragma unroll
        for (int u = 0; u < 4; ++u) { const int i = i0 + u * NGT; if (i < 32 * 64 * 4 * 64) { const int ln = i & 63, ks = (i >> 6) & 3, t = (i >> 8) & 63, g = i >> 14; const int c = ln & 15, q0 = 32 * ks + 8 * (ln >> 4), p0 = q0 & 63;
            const f32x4* pw = (const f32x4*)(PW + (size_t)((g * 65 + t + 1) * 64 + p0) * 2); const f32x4* cr = (const f32x4*)(Cre + (g * 16 + c) * 64 + p0); const f32x4* ci = (const f32x4*)(Cim + (g * 16 + c) * 64 + p0);
            pw4[u][0] = pw[0]; pw4[u][1] = pw[1]; pw4[u][2] = pw[2]; pw4[u][3] = pw[3]; cr4[u][0] = cr[0]; cr4[u][1] = cr[1]; ci4[u][0] = ci[0]; ci4[u][1] = ci[1]; } }
#pragma unroll
        for (int u = 0; u < 4; ++u) { const int i = i0 + u * NGT; if (i < 32 * 64 * 4 * 64) { const int im = (32 * ((i >> 6) & 3) + 8 * ((i & 63) >> 4)) >= 64; float v[8];
#pragma unroll
            for (int k = 0; k < 8; ++k) { const float pr = pw4[u][k >> 1][2 * (k & 1)], pi = pw4[u][k >> 1][2 * (k & 1) + 1], cr = cr4[u][k >> 2][k & 3], ci = ci4[u][k >> 2][k & 3]; const float re = cr * pr - ci * pi, ig = cr * pi + ci * pr; v[k] = im ? -ig : re; }
            u32x4 o; o.x = pk2(v[0], v[1]); o.y = pk2(v[2], v[3]); o.z = pk2(v[4], v[5]); o.w = pk2(v[6], v[7]);
            *(u32x4*)(FT + (size_t)i * 8) = o; } } } }
    { bf16_t* ET = (bf16_t*)(ws + WS_ET);
      for (int i0 = gt; i0 < 32 * 8 * 32 * 64; i0 += 4 * NGT) { float pr4[4], pi4[4]; f32x4 bb4[4][4];
#pragma unroll
        for (int u = 0; u < 4; ++u) { const int i = i0 + u * NGT; if (i < 32 * 8 * 32 * 64) { const int ln = i & 63, ks = (i >> 6) & 31, rb = (i >> 11) & 7, g = i >> 14; const int q = 16 * rb + (ln & 15), p = q & 63, tau = 2 * ks + (ln >> 5), c0 = 8 * ((ln >> 4) & 1);
            pr4[u] = PW[(size_t)((g * 65 + 63 - tau) * 64 + p) * 2]; pi4[u] = PW[(size_t)((g * 65 + 63 - tau) * 64 + p) * 2 + 1]; const f32x4* bb = (const f32x4*)(BB + (size_t)((g * 64 + p) * 16 + c0) * 2);
            bb4[u][0] = bb[0]; bb4[u][1] = bb[1]; bb4[u][2] = bb[2]; bb4[u][3] = bb[3]; } }
#pragma unroll
        for (int u = 0; u < 4; ++u) { const int i = i0 + u * NGT; if (i < 32 * 8 * 32 * 64) { const int im = ((16 * ((i >> 11) & 7) + (i & 15)) >> 6) & 1; float v[8];
#pragma unroll
            for (int k = 0; k < 8; ++k) { const float br = bb4[u][k >> 1][2 * (k & 1)], bi = bb4[u][k >> 1][2 * (k & 1) + 1]; v[k] = im ? (pr4[u] * bi + pi4[u] * br) : (pr4[u] * br - pi4[u] * bi); }
            u32x4 o; o.x = pk2(v[0], v[1]); o.y = pk2(v[2], v[3]); o.z = pk2(v[4], v[5]); o.w = pk2(v[6], v[7]);
            *(u32x4*)(ET + (size_t)i * 8) = o; } } } }
}
__device__ __forceinline__ void p2_rows(ArgsRef A, int lane, int wave) {
    unsigned char* ws = A.ws; const int gw = blockIdx.x * 8 + wave, NGW = gridDim.x * 8;
    const bf16_t* H1 = (const bf16_t*)(ws + WS_H1); bf16_t* CQ = (bf16_t*)(ws + WS_CQ); bf16_t* CKV = (bf16_t*)(ws + WS_CKV);
    float* KROT = (float*)(ws + WS_KROT); float* ROTSS = (float*)(ws + WS_ROTSS); const float* RP = (const float*)(ws + WS_ROPE);
    for (int r0 = gw; r0 < MV; r0 += 2 * NGW) {
      u32x4 qw[2], kw[2]; unsigned pe1[2], pe2[2];
#pragma unroll
      for (int u = 0; u < 2; ++u) { const int r = r0 + u * NGW; qw[u] = (u32x4){0, 0, 0, 0}; kw[u] = (u32x4){0, 0, 0, 0}; pe1[u] = 0; pe2[u] = 0;
        if (r < MV) { const bf16_t* hrow = H1 + (size_t)r * NIN; if (lane < 48) qw[u] = *(const u32x4*)(hrow + lane * 8); if (lane < 32) kw[u] = *(const u32x4*)(hrow + 384 + lane * 8); if (lane < 16) { pe1[u] = hrow[1152 + lane]; pe2[u] = hrow[1168 + lane]; } } }
#pragma unroll
      for (int u = 0; u < 2; ++u) { const int r = r0 + u * NGW; if (r < MV) {
        int pos; size_t kvrow; float* okv; float* okr;
        if (r < MPR) { pos = r & 4095; kvrow = (size_t)r; okv = A.out + O_KVP + (size_t)r * 256; okr = A.out + O_KRP + (size_t)r * 32; }
        else { const int s = r - MPR, b = s >> 4, t = s & 15; pos = 2048 + t; kvrow = (size_t)(16384 + b * SKVB + 2048 + t); okv = A.out + O_KVS + (size_t)s * 256; okr = A.out + O_KRS + (size_t)s * 32; }
        { const u32x4 w = qw[u]; float v[8]; v[0] = bflo(w.x); v[1] = bfhi(w.x); v[2] = bflo(w.y); v[3] = bfhi(w.y); v[4] = bflo(w.z); v[5] = bfhi(w.z); v[6] = bflo(w.w); v[7] = bfhi(w.w); float ss = 0.f;
#pragma unroll
          for (int k = 0; k < 8; ++k) ss += v[k] * v[k];
          const float rs = rsqrtf(wave_sum(ss) * (1.f / 384.f) + EPSF);
          if (lane < 48) { const f32x4 g0 = *(const f32x4*)(A.in[9] + lane * 8), g1 = *(const f32x4*)(A.in[9] + lane * 8 + 4);
            u32x4 o; o.x = pk2(v[0] * rs * g0.x, v[1] * rs * g0.y); o.y = pk2(v[2] * rs * g0.z, v[3] * rs * g0.w); o.z = pk2(v[4] * rs * g1.x, v[5] * rs * g1.y); o.w = pk2(v[6] * rs * g1.z, v[7] * rs * g1.w);
            *(u32x4*)(CQ + (size_t)r * 384 + lane * 8) = o; } }
        { const u32x4 w = kw[u]; float v[8]; v[0] = bflo(w.x); v[1] = bfhi(w.x); v[2] = bflo(w.y); v[3] = bfhi(w.y); v[4] = bflo(w.z); v[5] = bfhi(w.z); v[6] = bflo(w.w); v[7] = bfhi(w.w); float ss = 0.f;
#pragma unroll
          for (int k = 0; k < 8; ++k) ss += v[k] * v[k];
          const float rs = rsqrtf(wave_sum(ss) * (1.f / 256.f) + EPSF);
          if (lane < 32) { const f32x4 g0 = *(const f32x4*)(A.in[11] + lane * 8), g1 = *(const f32x4*)(A.in[11] + lane * 8 + 4);
            f32x4 c0, c1; c0.x = v[0] * rs * g0.x; c0.y = v[1] * rs * g0.y; c0.z = v[2] * rs * g0.z; c0.w = v[3] * rs * g0.w; c1.x = v[4] * rs * g1.x; c1.y = v[5] * rs * g1.y; c1.z = v[6] * rs * g1.z; c1.w = v[7] * rs * g1.w;
            *(f32x4*)(okv + lane * 8) = c0; *(f32x4*)(okv + lane * 8 + 4) = c1;
            u32x4 o; o.x = pk2(c0.x, c0.y); o.y = pk2(c0.z, c0.w); o.z = pk2(c1.x, c1.y); o.w = pk2(c1.z, c1.w);
            *(u32x4*)(CKV + kvrow * 256 + lane * 8) = o; } }
        { float ss = 0.f;
          if (lane < 16) { const float x1 = __uint_as_float(pe1[u] << 16), x2 = __uint_as_float(pe2[u] << 16); const float c = RP[pos * 32 + lane], s = RP[pos * 32 + 16 + lane];
            const float o1 = x1 * c - x2 * s, o2 = x2 * c + x1 * s; okr[lane] = o1; okr[16 + lane] = o2; KROT[kvrow * 32 + lane] = o1; KROT[kvrow * 32 + 16 + lane] = o2; ss = o1 * o1 + o2 * o2; }
          ss = wave_sum(ss); if (lane == 0) ROTSS[kvrow] = ss; }
      } }
    }
}
__device__ __forceinline__ void p2_s5loc(ArgsRef A, int lane, int wave) {
    unsigned char* ws = A.ws; const int gw = blockIdx.x * 8 + wave, NGW = gridDim.x * 8;
    const bf16_t* H1 = (const bf16_t*)(ws + WS_H1); const bf16_t* ET = (const bf16_t*)(ws + WS_ET); float* SLOC = (float*)(ws + WS_SLOC);
    for (int w = gw; w < 2048; w += NGW) {
        const int g = w >> 6, ntile = (w >> 2) & 15, rq = w & 3, b = ntile >> 2, chunk = 16 * (ntile & 3) + (lane & 15), kq = lane >> 4;
        f32x4 acc0 = (f32x4){0.f, 0.f, 0.f, 0.f}, acc1 = (f32x4){0.f, 0.f, 0.f, 0.f};
        const bf16_t* ub = H1 + (size_t)(b * 4096 + chunk * 64 + (kq >> 1)) * NIN + 640 + g * 16 + 8 * (kq & 1);
        const bf16_t* e0 = ET + ((size_t)((g * 8 + 2 * rq) * 32) * 64 + lane) * 8; const bf16_t* e1 = e0 + (size_t)32 * 64 * 8;
#pragma unroll 8
        for (int ks = 0; ks < 32; ++ks) {
            const bf16x8 bf = *(const bf16x8*)(ub + (size_t)(2 * ks) * NIN), a0 = *(const bf16x8*)(e0 + (size_t)ks * 512), a1 = *(const bf16x8*)(e1 + (size_t)ks * 512);
            acc0 = __builtin_amdgcn_mfma_f32_16x16x32_bf16(a0, bf, acc0, 0, 0, 0); acc1 = __builtin_amdgcn_mfma_f32_16x16x32_bf16(a1, bf, acc1, 0, 0, 0);
        }
        float* o = SLOC + (size_t)((b * 32 + g) * 64 + chunk) * 128 + 32 * rq + 4 * kq;
        *(f32x4*)o = acc0; *(f32x4*)(o + 16) = acc1;
    }
}

struct EpiKV {
    static constexpr bool PERM = false, AFTER_DRAIN = false;
    ArgsRef A;
    __device__ __forceinline__ void operator()(const f32x4 (&acc)[2][2][4][2], const pg8::Unit& u, int wr, int wc, int fr, int fq) const {
        bf16_t* KB = (bf16_t*)(A.ws + WS_KB); bf16_t* VT = (bf16_t*)A.out; const float* KROT = (const float*)(A.ws + WS_KROT); const float* ROTSS = (const float*)(A.ws + WS_ROTSS); const float* gk = A.in[14];
        const int head = (u.pn & 1) * 4 + wc; const bool isv = u.pn >= 2;
        if (!isv) {
            f32x4 g4[2][2];
#pragma unroll
            for (int bj = 0; bj < 2; ++bj)
#pragma unroll
                for (int n = 0; n < 2; ++n) g4[bj][n] = *(const f32x4*)(gk + 32 * bj + 16 * n + 4 * fq);
            const f32x4 g0 = *(const f32x4*)(gk + 64 + 8 * fq), g1 = *(const f32x4*)(gk + 68 + 8 * fq);
#pragma unroll
            for (int ai = 0; ai < 2; ++ai) {
                float rss[4]; f32x4 r0[4], r1[4];
#pragma unroll
                for (int m = 0; m < 4; ++m) { const size_t row = (size_t)u.pm * 256 + ai * 128 + wr * 64 + m * 16 + fr; rss[m] = ROTSS[row]; r0[m] = *(const f32x4*)(KROT + row * 32 + 8 * fq); r1[m] = *(const f32x4*)(KROT + row * 32 + 8 * fq + 4); }
#pragma unroll
                for (int m = 0; m < 4; ++m) { const size_t row = (size_t)u.pm * 256 + ai * 128 + wr * 64 + m * 16 + fr; float ss = 0.f;
#pragma unroll
                    for (int bj = 0; bj < 2; ++bj)
#pragma unroll
                        for (int n = 0; n < 2; ++n) { const f32x4 x = acc[ai][bj][m][n]; ss += (x.x * x.x + x.y * x.y) + (x.z * x.z + x.w * x.w); }
                    ss += __shfl_xor(ss, 16); ss += __shfl_xor(ss, 32); ss += rss[m];
                    const float rs = rsqrtf(ss * (1.f / 96.f) + EPSF); bf16_t* kp = KB + ((size_t)head * MKV + row) * 96;
#pragma unroll
                    for (int bj = 0; bj < 2; ++bj)
#pragma unroll
                        for (int n = 0; n < 2; ++n) { const int d = 32 * bj + 16 * n + 4 * fq; const f32x4 x = acc[ai][bj][m][n]; const f32x4 g = g4[bj][n];
                            u32x2 w; w.x = pk2(x.x * rs * g.x, x.y * rs * g.y); w.y = pk2(x.z * rs * g.z, x.w * rs * g.w); *(u32x2*)(kp + d) = w; }
                    u32x4 w; w.x = pk2(r0[m].x * rs * g0.x, r0[m].y * rs * g0.y); w.y = pk2(r0[m].z * rs * g0.z, r0[m].w * rs * g0.w); w.z = pk2(r1[m].x * rs * g1.x, r1[m].y * rs * g1.y); w.w = pk2(r1[m].z * rs * g1.z, r1[m].w * rs * g1.w);
                    *(u32x4*)(kp + 64 + 8 * fq) = w; } }
        } else {
            const int q = fr & 3;
#pragma unroll
            for (int ai = 0; ai < 2; ++ai)
#pragma unroll
                for (int m = 0; m < 4; ++m) { const size_t row4 = (size_t)u.pm * 256 + ai * 128 + wr * 64 + m * 16 + (fr & ~3);
#pragma unroll
                    for (int bj = 0; bj < 2; ++bj)
#pragma unroll
                        for (int n = 0; n < 2; ++n) { const f32x4 x = acc[ai][bj][m][n];
                            const float s0 = (q & 1) ? x.x : x.y, s1 = (q & 1) ? x.z : x.w;
                            const float t0 = __shfl_xor(s0, 1), t1 = __shfl_xor(s1, 1);
                            const float a0 = (q & 1) ? t0 : x.x, a1 = (q & 1) ? x.y : t0, a2 = (q & 1) ? t1 : x.z, a3 = (q & 1) ? x.w : t1;
                            const float u0 = (q & 2) ? a0 : a2, u1 = (q & 2) ? a1 : a3;
                            const float v0 = __shfl_xor(u0, 2), v1 = __shfl_xor(u1, 2);
                            const float y0 = (q & 2) ? v0 : a0, y1 = (q & 2) ? v1 : a1, y2 = (q & 2) ? a2 : v0, y3 = (q & 2) ? a3 : v1;
                            const int dv = 32 * bj + 16 * n + 4 * fq + q; u32x2 w; w.x = pk2(y0, y1); w.y = pk2(y2, y3);
                            *(u32x2*)(VT + (size_t)(head * 64 + dv) * MKV + row4) = w; } }
        }
    }
};
struct EpiGLU {
    static constexpr bool PERM = true, AFTER_DRAIN = false;
    ArgsRef A;
    __device__ __forceinline__ void operator()(const f32x4 (&acc)[2][2][4][2], const pg8::Unit& u, int wr, int wc, int fr, int fq) const {
        const bf16_t* G = (const bf16_t*)(A.ws + WS_G); bf16_t* MIX = (bf16_t*)(A.ws + WS_MIX); const float* bias = A.in[24];
        f32x4 b0[2], b1[2];
#pragma unroll
        for (int bj = 0; bj < 2; ++bj) { const int col = u.pn * 256 + bj * 128 + wc * 32 + 8 * fq; b0[bj] = *(const f32x4*)(bias + col); b1[bj] = *(const f32x4*)(bias + col + 4); }
#pragma unroll
        for (int ai = 0; ai < 2; ++ai) { u32x4 gw[4][2];
#pragma unroll
            for (int m = 0; m < 4; ++m)
#pragma unroll
                for (int bj = 0; bj < 2; ++bj) { const size_t row = (size_t)u.pm * 256 + ai * 128 + wr * 64 + m * 16 + fr; gw[m][bj] = *(const u32x4*)(G + row * 512 + u.pn * 256 + bj * 128 + wc * 32 + 8 * fq); }
#pragma unroll
            for (int m = 0; m < 4; ++m)
#pragma unroll
                for (int bj = 0; bj < 2; ++bj) { const size_t row = (size_t)u.pm * 256 + ai * 128 + wr * 64 + m * 16 + fr; const int col = u.pn * 256 + bj * 128 + wc * 32 + 8 * fq;
                    const f32x4 z0 = acc[ai][bj][m][0] + b0[bj], z1 = acc[ai][bj][m][1] + b1[bj]; const u32x4 g = gw[m][bj];
                    u32x4 o; o.x = pk2(bflo(g.x) * sigmoidf_(z0.x), bfhi(g.x) * sigmoidf_(z0.y)); o.y = pk2(bflo(g.y) * sigmoidf_(z0.z), bfhi(g.y) * sigmoidf_(z0.w));
                    o.z = pk2(bflo(g.z) * sigmoidf_(z1.x), bfhi(g.z) * sigmoidf_(z1.y)); o.w = pk2(bflo(g.w) * sigmoidf_(z1.z), bfhi(g.w) * sigmoidf_(z1.w));
                    *(u32x4*)(MIX + row * 1024 + 512 + col) = o; } }
    }
};
struct EpiOut {
    static constexpr bool PERM = false, AFTER_DRAIN = false;
    ArgsRef A;
    __device__ __forceinline__ void operator()(const f32x4 (&acc)[2][2][4][2], const pg8::Unit& u, int wr, int wc, int fr, int fq) const {
        const float* xp = A.in[0]; float* out = A.out; bf16_t* HB = (bf16_t*)(A.ws + WS_HB); float* SS = (float*)(A.ws + WS_SS);
#pragma unroll
        for (int ai = 0; ai < 2; ++ai) { f32x4 xv[4][2][2];
#pragma unroll
            for (int m = 0; m < 4; ++m)
#pragma unroll
                for (int bj = 0; bj < 2; ++bj)
#pragma unroll
                    for (int n = 0; n < 2; ++n) { const size_t row = (size_t)u.pm * 256 + ai * 128 + wr * 64 + m * 16 + fr; xv[m][bj][n] = *(const f32x4*)(xp + row * 1024 + u.pn * 256 + bj * 128 + wc * 32 + 16 * n + 4 * fq); }
#pragma unroll
            for (int m = 0; m < 4; ++m) { const size_t row = (size_t)u.pm * 256 + ai * 128 + wr * 64 + m * 16 + fr; float ss = 0.f;
#pragma unroll
                for (int bj = 0; bj < 2; ++bj)
#pragma unroll
                    for (int n = 0; n < 2; ++n) { const int col = u.pn * 256 + bj * 128 + wc * 32 + 16 * n + 4 * fq; const f32x4 h = acc[ai][bj][m][n] + xv[m][bj][n];
                        *(f32x4*)(out + row * 1024 + col) = h; ss += (h.x * h.x + h.y * h.y) + (h.z * h.z + h.w * h.w); u32x2 w; w.x = pk2(h.x, h.y); w.y = pk2(h.z, h.w); *(u32x2*)(HB + row * 1024 + col) = w; }
                ss += __shfl_xor(ss, 16); ss += __shfl_xor(ss, 32); if (fq == 0) SS[row * 16 + u.pn * 4 + wc] = ss; } }
    }
};
struct EpiNull {
    static constexpr bool PERM = false, AFTER_DRAIN = false;
    ArgsRef A;
    __device__ __forceinline__ void operator()(const f32x4 (&acc)[2][2][4][2], const pg8::Unit& u, int wr, int wc, int fr, int fq) const {
        float s = 0.f;
#pragma unroll
        for (int ai = 0; ai < 2; ++ai)
#pragma unroll
            for (int bj = 0; bj < 2; ++bj)
#pragma unroll
                for (int m = 0; m < 4; ++m)
#pragma unroll
                    for (int n = 0; n < 2; ++n) s += acc[ai][bj][m][n].x + acc[ai][bj][m][n].y + acc[ai][bj][m][n].z + acc[ai][bj][m][n].w;
        if (s == 12345.678f) ((float*)(A.ws + WS_CTL))[1024] = s;
    }
};
struct EpiDown {
    static constexpr bool PERM = false, AFTER_DRAIN = false;
    ArgsRef A;
    __device__ __forceinline__ void operator()(const f32x4 (&acc)[2][2][4][2], const pg8::Unit& u, int wr, int wc, int fr, int fq) const {
        float* out = A.out;
#pragma unroll
        for (int ai = 0; ai < 2; ++ai) { f32x4 hv[4][2][2];
#pragma unroll
            for (int m = 0; m < 4; ++m)
#pragma unroll
                for (int bj = 0; bj < 2; ++bj)
#pragma unroll
                    for (int n = 0; n < 2; ++n) { const size_t row = (size_t)u.pm * 256 + ai * 128 + wr * 64 + m * 16 + fr; hv[m][bj][n] = *(const f32x4*)(out + row * 1024 + u.pn * 256 + bj * 128 + wc * 32 + 16 * n + 4 * fq); }
#pragma unroll
            for (int m = 0; m < 4; ++m)
#pragma unroll
                for (int bj = 0; bj < 2; ++bj)
#pragma unroll
                    for (int n = 0; n < 2; ++n) { const size_t row = (size_t)u.pm * 256 + ai * 128 + wr * 64 + m * 16 + fr; *(f32x4*)(out + row * 1024 + u.pn * 256 + bj * 128 + wc * 32 + 16 * n + 4 * fq) = hv[m][bj][n] + acc[ai][bj][m][n]; } }
    }
};
__device__ __forceinline__ float dpp_ror1(float v) { return __int_as_float(__builtin_amdgcn_mov_dpp(__float_as_int(v), 0x121, 0xf, 0xf, false)); }
__device__ __forceinline__ float dpp_ror2(float v) { return __int_as_float(__builtin_amdgcn_mov_dpp(__float_as_int(v), 0x122, 0xf, 0xf, false)); }
__device__ __forceinline__ float dpp_shr1(float old, float v) { return __int_as_float(__builtin_amdgcn_update_dpp(__float_as_int(old), __float_as_int(v), 0x111, 0xf, 0xf, false)); }
__device__ __forceinline__ float dpp_shr2(float old, float v) { return __int_as_float(__builtin_amdgcn_update_dpp(__float_as_int(old), __float_as_int(v), 0x112, 0xf, 0xf, false)); }
struct EpiUp {
    static constexpr bool PERM = false, AFTER_DRAIN = false;
    ArgsRef A; LAS float* xch;
    __device__ __forceinline__ void operator()(f32x4 (&acc)[2][2][4][2], const pg8::Unit& u, int wr, int wc, int fr, int fq) const {
        bf16_t* ACT = (bf16_t*)(A.ws + WS_ACT); float* SIDE = (float*)(A.ws + WS_SIDE); const float* SS = (const float*)(A.ws + WS_SS); const float* wdw = A.in[28]; const float* bdw = A.in[29]; const float* hist = A.in[6]; float* out = A.out;
        const int pm = u.pm, pn = u.pn; const bool sample = pm == 64; const int cw = 32 * wc + 4 * fq;
        f32x4 w0a[2][2], w1a[2][2], w2a[2][2], bba[2][2];
#pragma unroll
        for (int n = 0; n < 2; ++n)
#pragma unroll
            for (int bj = 0; bj < 2; ++bj) { const int sc = bj * 2816 + pn * 128 + cw + 16 * n; w0a[n][bj] = *(const f32x4*)(wdw + sc); w1a[n][bj] = *(const f32x4*)(wdw + 5632 + sc); w2a[n][bj] = *(const f32x4*)(wdw + 2 * 5632 + sc); bba[n][bj] = *(const f32x4*)(bdw + sc); }
#pragma unroll
        for (int ai = 0; ai < 2; ++ai)
#pragma unroll
            for (int m = 0; m < 4; ++m) { const size_t row = (size_t)pm * 256 + ai * 128 + wr * 64 + m * 16 + fr;
                float s;
                if (sample) { s = 256.f; if (ai == 0) { const f32x4* sq = (const f32x4*)((const float*)(A.ws + WS_SSS) + (row - MPR) * 64 + 16 * fq); s = 0.f;
#pragma unroll
                    for (int k = 0; k < 4; ++k) { const f32x4 q = sq[k]; s += (q.x + q.y) + (q.z + q.w); } } }
                else { const f32x4 a = *(const f32x4*)(SS + row * 16 + 4 * fq); s = (a.x + a.y) + (a.z + a.w); }
                s += __shfl_xor(s, 16); s += __shfl_xor(s, 32);
                const float rs = rsqrtf(s * (1.f / 1024.f) + EPSF);
#pragma unroll
                for (int bj = 0; bj < 2; ++bj)
#pragma unroll
                    for (int n = 0; n < 2; ++n) acc[ai][bj][m][n] *= rs; }
        if (fr >= 14) {
#pragma unroll
            for (int ai = 0; ai < 2; ++ai)
#pragma unroll
                for (int bj = 0; bj < 2; ++bj)
#pragma unroll
                    for (int n = 0; n < 2; ++n) *(LAS f32x4*)(xch + ((2 * ai + wr) * 2 + (fr - 14)) * 256 + 128 * bj + cw + 16 * n) = acc[ai][bj][3][n];
            if (wr == 1) {
#pragma unroll
                for (int bj = 0; bj < 2; ++bj)
#pragma unroll
                    for (int n = 0; n < 2; ++n) { *(f32x4*)(SIDE + (size_t)(pm * 4 + 2 + fr - 14) * 5632 + pn * 256 + 128 * bj + cw + 16 * n) = acc[1][bj][3][n];
                        if (!sample && (pm & 15) == 15) *(f32x4*)(out + O_CONVP + (size_t)((pm >> 4) * 2 + fr - 14) * 5632 + bj * 2816 + pn * 128 + cw + 16 * n) = acc[1][bj][3][n]; } }
            if (sample) {
#pragma unroll
                for (int m = 0; m < 4; ++m)
#pragma unroll
                    for (int bj = 0; bj < 2; ++bj)
#pragma unroll
                        for (int n = 0; n < 2; ++n) *(f32x4*)(out + O_CONVS + (size_t)((4 * wr + m) * 2 + fr - 14) * 5632 + bj * 2816 + pn * 128 + cw + 16 * n) = acc[0][bj][m][n]; }
        }
        if (fr < 2 && wr == 0) {
#pragma unroll
            for (int bj = 0; bj < 2; ++bj)
#pragma unroll
                for (int n = 0; n < 2; ++n) *(f32x4*)(SIDE + (size_t)(pm * 4 + fr) * 5632 + pn * 256 + 128 * bj + cw + 16 * n) = acc[0][bj][0][n]; }
        asm volatile("s_waitcnt lgkmcnt(0)\n\ts_barrier" ::: "memory");
        const bool t14 = fr >= 14;
#pragma unroll
        for (int n = 0; n < 2; ++n) {
            f32x4 w0[2], w1[2], w2[2], bb[2];
#pragma unroll
            for (int bj = 0; bj < 2; ++bj) { w0[bj] = w0a[n][bj]; w1[bj] = w1a[n][bj]; w2[bj] = w2a[n][bj]; bb[bj] = bba[n][bj]; }
#pragma unroll
            for (int ai = 0; ai < 2; ++ai)
#pragma unroll
                for (int m = 0; m < 4; ++m) { const size_t row = (size_t)pm * 256 + ai * 128 + wr * 64 + m * 16 + fr; f32x4 cv[2];
#pragma unroll
                    for (int bj = 0; bj < 2; ++bj) { f32x4 prev = (f32x4){0.f, 0.f, 0.f, 0.f};
                        if (sample) { if (t14 && ai == 0) prev = *(const f32x4*)(hist + (size_t)((4 * wr + m) * 2 + fr - 14) * 5632 + bj * 2816 + pn * 128 + cw + 16 * n); }
                        else if (m > 0) prev = acc[ai][bj][m > 0 ? m - 1 : 0][n];
                        else if (2 * ai + wr > 0) { if (t14) prev = *(const LAS f32x4*)(xch + ((2 * ai + wr - 1) * 2 + (fr - 14)) * 256 + 128 * bj + cw + 16 * n); }
                        const f32x4 cur = acc[ai][bj][m][n]; f32x4 p1, p2;
#pragma unroll
                        for (int j = 0; j < 4; ++j) { p1[j] = dpp_shr1(dpp_ror1(prev[j]), cur[j]); p2[j] = dpp_shr2(dpp_ror2(prev[j]), cur[j]); }
                        cv[bj] = w0[bj] * p2 + (w1[bj] * p1 + (w2[bj] * cur + bb[bj])); }
                    u32x2 w; w.x = pk2(cv[0].x * sigmoidf_(cv[0].x) * cv[1].x, cv[0].y * sigmoidf_(cv[0].y) * cv[1].y); w.y = pk2(cv[0].z * sigmoidf_(cv[0].z) * cv[1].z, cv[0].w * sigmoidf_(cv[0].w) * cv[1].w);
                    *(u32x2*)(ACT + row * 2816 + pn * 128 + cw + 16 * n) = w; }
        }
    }
};
__device__ __forceinline__ int crow(int r, int hi) { return (r & 3) + 8 * (r >> 2) + 4 * hi; }
__device__ __forceinline__ bf16x8 pack8(const f32x16& p, int b) {
    u32x4 w; w.x = pk2(p[b + 0], p[b + 1]); w.y = pk2(p[b + 2], p[b + 3]); w.z = pk2(p[b + 4], p[b + 5]); w.w = pk2(p[b + 6], p[b + 7]); return __builtin_bit_cast(bf16x8, w);
}
constexpr int AT_KROW = 208, AT_VROW = 136, AT_KB = 13312, AT_V0 = 4 * 13312, AT_VB = 8704;
__device__ __forceinline__ float max3f(float a, float b, float c) { float r; asm("v_max3_f32 %0, %1, %2, %3" : "=v"(r) : "v"(a), "v"(b), "v"(c)); return r; }
__device__ __forceinline__ void attn_unit(const int AV, ArgsRef A, bool sample, int b, int h, int qb, LAS unsigned char* lds, int tid, int lane, int wave) {
    unsigned char* ws = A.ws;
    const bf16_t* QRAW = (const bf16_t*)(ws + WS_QRAW); const bf16_t* KB = (const bf16_t*)(ws + WS_KB); const bf16_t* VT = (const bf16_t*)A.out; bf16_t* MIX = (bf16_t*)(ws + WS_MIX);
    const float* RP = (const float*)(ws + WS_ROPE); const float* gq = A.in[13];
    const int r32 = lane & 31, hi = lane >> 5;
    int NT, myNT, kvbase, qrow, pos, kvalid;
    if (sample) { NT = 33; myNT = wave == 0 ? 33 : 0; kvbase = 16384 + b * SKVB; qrow = MPR + 16 * b + (r32 & 15); pos = 2048 + (r32 & 15); kvalid = 16; }
    else { const int q0 = 256 * qb + 32 * wave; NT = 4 * qb + 4; myNT = (q0 >> 6) + 1; kvbase = b * 4096; qrow = b * 4096 + q0 + r32; pos = q0 + r32; kvalid = 64; }
    bf16x8 qf[6];
    const bf16_t* kg = KB + ((size_t)h * MKV + kvbase) * 96;
    const bf16_t* vg = VT + (size_t)(h * 64 + (tid >> 3)) * MKV + kvbase + 8 * (tid & 7);
    const int kd0 = (tid / 12) * AT_KROW + (tid % 12) * 16, kd1 = ((tid + 512) / 12) * AT_KROW + ((tid + 512) % 12) * 16, vd = AT_V0 + (tid >> 3) * AT_VROW + (tid & 7) * 16;
    u32x4 ka0, ka1 = (u32x4){0, 0, 0, 0}, va = (u32x4){0, 0, 0, 0}, kb0 = (u32x4){0, 0, 0, 0}, kb1 = (u32x4){0, 0, 0, 0}, vb_ = (u32x4){0, 0, 0, 0};
#define AT_LDK(t_, R0, R1) do { const bf16_t* kt_ = kg + (size_t)(t_) * 64 * 96; R0 = *(const u32x4*)(kt_ + tid * 8); if (tid < 256) R1 = *(const u32x4*)(kt_ + (tid + 512) * 8); } while (0)
#define AT_STK(slot_, R0, R1) do { *(LAS u32x4*)(lds + (slot_) * AT_KB + kd0) = R0; if (tid < 256) *(LAS u32x4*)(lds + (slot_) * AT_KB + kd1) = R1; } while (0)
#define AT_LDV(t_, RV) do { RV = *(const u32x4*)(vg + (t_) * 64); } while (0)
#define AT_STV(slot_, RV) do { *(LAS u32x2*)(lds + (slot_) * AT_VB + vd) = (u32x2){RV.x, RV.y}; *(LAS u32x2*)(lds + (slot_) * AT_VB + vd + 8) = (u32x2){RV.z, RV.w}; } while (0)
#define AT_QK(slot_, S0, S1) do { const LAS unsigned char* kb_ = lds + (slot_) * AT_KB + r32 * AT_KROW + hi * 16; \
        _Pragma("unroll") for (int d0 = 0; d0 < 6; ++d0) { const bf16x8 k0_ = *(const LAS bf16x8*)(kb_ + d0 * 32), k1_ = *(const LAS bf16x8*)(kb_ + 32 * AT_KROW + d0 * 32); \
            if (d0 == 0) { S0 = __builtin_amdgcn_mfma_f32_32x32x16_bf16(k0_, qf[0], zero16, 0, 0, 0); S1 = __builtin_amdgcn_mfma_f32_32x32x16_bf16(k1_, qf[0], zero16, 0, 0, 0); } \
            else { S0 = __builtin_amdgcn_mfma_f32_32x32x16_bf16(k0_, qf[d0], S0, 0, 0, 0); S1 = __builtin_amdgcn_mfma_f32_32x32x16_bf16(k1_, qf[d0], S1, 0, 0, 0); } } } while (0)
#define AT_MASK(S0, S1) do { _Pragma("unroll") for (int r = 0; r < 16; ++r) { if (crow(r, hi) >= kvalid) S0[r] = -1e30f; S1[r] = -1e30f; } } while (0)
    AT_LDK(0, ka0, ka1); AT_LDV(0, va); if (NT > 1) AT_LDK(1, kb0, kb1);
    { float v[6][8]; const bf16_t* qp = QRAW + (size_t)qrow * 768 + h * 96 + hi * 8;
#pragma unroll
      for (int d0 = 0; d0 < 6; ++d0) { const u32x4 w = *(const u32x4*)(qp + d0 * 16); v[d0][0] = bflo(w.x); v[d0][1] = bfhi(w.x); v[d0][2] = bflo(w.y); v[d0][3] = bfhi(w.y); v[d0][4] = bflo(w.z); v[d0][5] = bfhi(w.z); v[d0][6] = bflo(w.w); v[d0][7] = bfhi(w.w); }
      const float* rp = RP + pos * 32 + hi * 8; float ss = 0.f;
#pragma unroll
      for (int i = 0; i < 8; ++i) { const float c = rp[i], s = rp[16 + i], x1 = v[4][i], x2 = v[5][i]; v[4][i] = x1 * c - x2 * s; v[5][i] = x2 * c + x1 * s; }
#pragma unroll
      for (int d0 = 0; d0 < 6; ++d0)
#pragma unroll
          for (int i = 0; i < 8; ++i) ss += v[d0][i] * v[d0][i];
      ss += __shfl_xor(ss, 32);
      const float rs = rsqrtf(ss * (1.f / 96.f) + EPSF) * (0.10206207261596575f * 1.4426950408889634f);
#pragma unroll
      for (int d0 = 0; d0 < 6; ++d0) { const f32x4 g0 = *(const f32x4*)(gq + d0 * 16 + hi * 8), g1 = *(const f32x4*)(gq + d0 * 16 + hi * 8 + 4);
          u32x4 w; w.x = pk2(v[d0][0] * rs * g0.x, v[d0][1] * rs * g0.y); w.y = pk2(v[d0][2] * rs * g0.z, v[d0][3] * rs * g0.w); w.z = pk2(v[d0][4] * rs * g1.x, v[d0][5] * rs * g1.y); w.w = pk2(v[d0][6] * rs * g1.z, v[d0][7] * rs * g1.w);
          qf[d0] = __builtin_bit_cast(bf16x8, w); } }
    AT_STK(0, ka0, ka1); AT_STV(0, va); if (NT > 1) AT_STK(1, kb0, kb1);
    if (NT > 2) AT_LDK(2, kb0, kb1);
    if (NT > 1) AT_LDV(1, vb_);
    __syncthreads();
    float lrun = 0.f; f32x16 o0, o1, zero16, sa0, sa1, sb0, sb1;
#pragma unroll
    for (int r = 0; r < 16; ++r) { o0[r] = 0.f; o1[r] = 0.f; zero16[r] = 0.f; sa0[r] = 0.f; sa1[r] = 0.f; sb0[r] = 0.f; sb1[r] = 0.f; }
    if (myNT > 0) { AT_QK(0, sa0, sa1); if (NT == 1 && kvalid < 64) AT_MASK(sa0, sa1); }
    int vs3 = 0;
#define AT_COMPUTE(SC0, SC1, SN0, SN1) do { if (t < myNT) { \
              \
            bf16x8 kf_[12]; s16x4 vf_[16]; \
            { const LAS unsigned char* kb_ = lds + ((t + 1) & 3) * AT_KB + r32 * AT_KROW + hi * 16; \
              _Pragma("unroll") for (int d0 = 0; d0 < 6; ++d0) { kf_[2 * d0] = *(const LAS bf16x8*)(kb_ + d0 * 32); kf_[2 * d0 + 1] = *(const LAS bf16x8*)(kb_ + 32 * AT_KROW + d0 * 32); } \
            } \
            __builtin_amdgcn_sched_barrier(0); \
              \
            SN0 = __builtin_amdgcn_mfma_f32_32x32x16_bf16(kf_[0], qf[0], zero16, 0, 0, 0); SN1 = __builtin_amdgcn_mfma_f32_32x32x16_bf16(kf_[1], qf[0], zero16, 0, 0, 0); \
            _Pragma("unroll") for (int d0 = 1; d0 < 6; ++d0) { SN0 = __builtin_amdgcn_mfma_f32_32x32x16_bf16(kf_[2 * d0], qf[d0], SN0, 0, 0, 0); SN1 = __builtin_amdgcn_mfma_f32_32x32x16_bf16(kf_[2 * d0 + 1], qf[d0], SN1, 0, 0, 0); } \
            { const LAS unsigned char* vb = lds + AT_V0 + vs3 * AT_VB + r32 * AT_VROW + hi * 8; \
              _Pragma("unroll") for (int s = 0; s < 4; ++s) { const int kb2 = (32 * (s >> 1) + 16 * (s & 1)) * 2; \
                  vf_[4 * s] = *(const LAS s16x4*)(vb + kb2); vf_[4 * s + 1] = *(const LAS s16x4*)(vb + kb2 + 16); vf_[4 * s + 2] = *(const LAS s16x4*)(vb + 32 * AT_VROW + kb2); vf_[4 * s + 3] = *(const LAS s16x4*)(vb + 32 * AT_VROW + kb2 + 16); } } \
            float ps_ = 0.f; \
            _Pragma("unroll") for (int r = 0; r < 16; ++r) { if (AV != 3) { SC0[r] = __builtin_amdgcn_exp2f(SC0[r]); SC1[r] = __builtin_amdgcn_exp2f(SC1[r]); } ps_ += SC0[r] + SC1[r]; } \
            lrun += ps_; \
            bf16x8 pf[4]; pf[0] = pack8(SC0, 0); pf[1] = pack8(SC0, 8); pf[2] = pack8(SC1, 0); pf[3] = pack8(SC1, 8); \
            _Pragma("unroll") for (int i = 0; i < 12; ++i) { __builtin_amdgcn_sched_group_barrier(0x008, 1, 0); __builtin_amdgcn_sched_group_barrier(0x002, 7, 0); } \
            __builtin_amdgcn_sched_barrier(0); \
              \
            _Pragma("unroll") for (int s = 0; s < 4; ++s) { \
                const bf16x8 a0 = (bf16x8){vf_[4 * s][0], vf_[4 * s][1], vf_[4 * s][2], vf_[4 * s][3], vf_[4 * s + 1][0], vf_[4 * s + 1][1], vf_[4 * s + 1][2], vf_[4 * s + 1][3]}; \
                const bf16x8 a1 = (bf16x8){vf_[4 * s + 2][0], vf_[4 * s + 2][1], vf_[4 * s + 2][2], vf_[4 * s + 2][3], vf_[4 * s + 3][0], vf_[4 * s + 3][1], vf_[4 * s + 3][2], vf_[4 * s + 3][3]}; \
                o0 = __builtin_amdgcn_mfma_f32_32x32x16_bf16(a0, pf[s], o0, 0, 0, 0); o1 = __builtin_amdgcn_mfma_f32_32x32x16_bf16(a1, pf[s], o1, 0, 0, 0); } \
            if (t + 2 == NT && kvalid < 64) AT_MASK(SN0, SN1); } } while (0)
#define AT_ITER(RK0, RK1, RV, WK0, WK1, WV, SC0, SC1, SN0, SN1) do { \
        if (AV != 2 && t + 3 < NT) AT_LDK(t + 3, RK0, RK1); \
        if (AV != 2 && t + 2 < NT) AT_LDV(t + 2, RV); \
        asm volatile("" ::: "memory"); \
        AT_COMPUTE(SC0, SC1, SN0, SN1); \
        asm volatile("" ::: "memory"); \
        if (AV != 2 && t + 2 < NT) AT_STK((t + 2) & 3, WK0, WK1); \
        if (AV != 2 && t + 1 < NT) AT_STV(vs3 == 2 ? 0 : vs3 + 1, WV); \
        if (AV != 5) __syncthreads(); \
        vs3 = vs3 == 2 ? 0 : vs3 + 1; } while (0)
    for (int t0 = 0; t0 < NT; t0 += 2) {
        { const int t = t0; AT_ITER(ka0, ka1, va, kb0, kb1, vb_, sa0, sa1, sb0, sb1); }
        if (t0 + 1 < NT) { const int t = t0 + 1; AT_ITER(kb0, kb1, vb_, ka0, ka1, va, sb0, sb1, sa0, sa1); }
    }
#undef AT_ITER
#undef AT_COMPUTE
#undef AT_LDK
#undef AT_STK
#undef AT_LDV
#undef AT_STV
#undef AT_QK
#undef AT_MASK
    if (myNT > 0) {
        lrun += __shfl_xor(lrun, 32); const float inv = __builtin_amdgcn_rcpf(lrun);
        if (AV == 0 || lrun == 1234.5f) if (!sample || r32 < 16) { bf16_t* op = MIX + (size_t)qrow * 1024 + h * 64 + 4 * hi;
#pragma unroll
            for (int g4 = 0; g4 < 4; ++g4) { u32x2 w; w.x = pk2(o0[4 * g4] * inv, o0[4 * g4 + 1] * inv); w.y = pk2(o0[4 * g4 + 2] * inv, o0[4 * g4 + 3] * inv); *(u32x2*)(op + 8 * g4) = w;
                w.x = pk2(o1[4 * g4] * inv, o1[4 * g4 + 1] * inv); w.y = pk2(o1[4 * g4 + 2] * inv, o1[4 * g4 + 3] * inv); *(u32x2*)(op + 32 + 8 * g4) = w; } }
    }
}
__device__ __forceinline__ void s5y_item(ArgsRef A, int item, LAS unsigned char* lds, int tid, int lane, int wave) {
    unsigned char* ws = A.ws; const int g = item >> 3, ntp = item & 7, b = ntp >> 1;
    const bf16_t* H1 = (const bf16_t*)(ws + WS_H1); const bf16_t* KP = (const bf16_t*)(ws + WS_KP); const bf16_t* FT = (const bf16_t*)(ws + WS_FT); const float* SLOC = (const float*)(ws + WS_SLOC); const float* PW = (const float*)(ws + WS_POW);
    bf16_t* G = (bf16_t*)(ws + WS_G);
    const int ntl = wave >> 2, tq = wave & 3, ntile = 2 * ntp + ntl, n = lane & 15, kq = lane >> 4, chunk = 16 * (ntile & 3) + n, nks = 8 * tq + 8;
    const size_t row0 = (size_t)b * 4096 + (size_t)chunk * 64;
    const bf16_t* ubq = H1 + (row0 + (kq >> 1)) * NIN + 640 + g * 16 + 8 * (kq & 1);
    u32x4 st[12]; bf16x8 cur[8], nxt[8]; float lr = 0.f, li = 0.f;
    { const u32x4* s1 = (const u32x4*)(KP + (size_t)g * 64 * 512); const u32x4* s2 = (const u32x4*)(SLOC + (size_t)((b * 32 + g) * 64) * 128);
#pragma unroll
      for (int i = 0; i < 8; ++i) st[i] = s1[i * 512 + tid];
#pragma unroll
      for (int i = 0; i < 4; ++i) st[8 + i] = s2[i * 512 + tid]; }
#pragma unroll
    for (int i = 0; i < 8; ++i) { cur[i] = *(const bf16x8*)(ubq + (size_t)(2 * i) * NIN); nxt[i] = cur[i]; }
    if (wave < 2) { lr = PW[(size_t)((g * 65 + 64) * 64 + lane) * 2]; li = PW[(size_t)((g * 65 + 64) * 64 + lane) * 2 + 1]; }
#pragma unroll
    for (int i = 0; i < 8; ++i) *(LAS u32x4*)(lds + (size_t)(i * 512 + tid) * 16) = st[i];
#pragma unroll
    for (int i = 0; i < 4; ++i) *(LAS u32x4*)(lds + 81920 + (size_t)(i * 512 + tid) * 16) = st[8 + i];
    __syncthreads();
    if (wave < 2) { const int nt2 = 2 * ntp + wave, c0 = 16 * (nt2 & 3), p = lane;
        const LAS float* sl = (const LAS float*)(lds + 81920); float sr = 0.f, si = 0.f;
        for (int j = 0; j < c0; ++j) { const float ar = sl[j * 128 + p], ai = sl[j * 128 + 64 + p]; const float nr = lr * sr - li * si + ar, ni = lr * si + li * sr + ai; sr = nr; si = ni; }
        LAS bf16_t* sin = (LAS bf16_t*)(lds + 65536 + wave * 4352);
        for (int jj = 0; jj < 16; ++jj) { sin[jj * 136 + p] = (bf16_t)(pk2(sr, 0.f) & 0xffffu); sin[jj * 136 + 64 + p] = (bf16_t)(pk2(si, 0.f) & 0xffffu);
            const int j = c0 + jj; const float ar = sl[j * 128 + p], ai = sl[j * 128 + 64 + p]; const float nr = lr * sr - li * si + ar, ni = lr * si + li * sr + ai; sr = nr; si = ni; }
        if ((nt2 & 3) == 3) { int p2 = p; asm volatile("" : "+v"(p2)); A.out[O_S5RP + (size_t)(b * 32 + g) * 64 + p2] = sr; A.out[O_S5IP + (size_t)(b * 32 + g) * 64 + p2] = si; } }
    f32x4 acc[16];
#pragma unroll
    for (int i = 0; i < 16; ++i) acc[i] = (f32x4){0.f, 0.f, 0.f, 0.f};
    for (int kb = 0; kb < nks; kb += 8) {
        if (kb + 8 < nks) {
#pragma unroll
            for (int i = 0; i < 8; ++i) nxt[i] = *(const bf16x8*)(ubq + (size_t)(2 * (kb + 8 + i)) * NIN); }
#pragma unroll
        for (int i = 0; i < 8; ++i) { bf16x8 af[16];
#pragma unroll
            for (int tt = 0; tt < 16; ++tt) { const int j = 16 * tq + tt - 2 * (kb + i); af[tt] = *(const LAS bf16x8*)(lds + (j >= 0 ? j : 0) * 1024 + lane * 16); }
            __builtin_amdgcn_sched_barrier(0);
#pragma unroll
            for (int tt = 0; tt < 16; ++tt) { const int j = 16 * tq + tt - 2 * (kb + i); if (j >= 0) acc[tt] = __builtin_amdgcn_mfma_f32_16x16x32_bf16(af[tt], cur[i], acc[tt], 0, 0, 0); }
            __builtin_amdgcn_sched_barrier(0); }
#pragma unroll
        for (int i = 0; i < 8; ++i) cur[i] = nxt[i];
    }
    const bf16_t* fq_ = FT + ((size_t)((g * 64 + 16 * tq) * 4) * 64 + lane) * 8;
    bf16x8 fa[2][16];
#pragma unroll
    for (int tt = 0; tt < 16; ++tt) fa[0][tt] = *(const bf16x8*)(fq_ + (size_t)(tt * 4 + 0) * 512);
    __syncthreads();
    const f32x4 dv = *(const f32x4*)(A.in[22] + g * 16 + 4 * kq); u32x2 uw[16];
#pragma unroll
    for (int ks = 0; ks < 4; ++ks) {
        if (ks < 3) {
#pragma unroll
            for (int tt = 0; tt < 16; ++tt) fa[(ks + 1) & 1][tt] = *(const bf16x8*)(fq_ + (size_t)(tt * 4 + ks + 1) * 512); }
        else {
#pragma unroll
            for (int tt = 0; tt < 16; ++tt) uw[tt] = *(const u32x2*)(H1 + (row0 + 16 * tq + tt) * NIN + 640 + g * 16 + 4 * kq); }
        const bf16x8 bs = *(const LAS bf16x8*)(lds + 65536 + ntl * 4352 + n * 272 + (32 * ks + 8 * kq) * 2);
#pragma unroll
        for (int tt = 0; tt < 16; ++tt) acc[tt] = __builtin_amdgcn_mfma_f32_16x16x32_bf16(fa[ks & 1][tt], bs, acc[tt], 0, 0, 0);
    }
#pragma unroll
    for (int tt = 0; tt < 16; ++tt) { const size_t row = row0 + 16 * tq + tt;
        const float y0 = acc[tt].x + dv.x * bflo(uw[tt].x), y1 = acc[tt].y + dv.y * bfhi(uw[tt].x), y2 = acc[tt].z + dv.z * bflo(uw[tt].y), y3 = acc[tt].w + dv.w * bfhi(uw[tt].y);
        u32x2 w; w.x = pk2(gelu_tanh(y0), gelu_tanh(y1)); w.y = pk2(gelu_tanh(y2), gelu_tanh(y3)); *(u32x2*)(G + row * 512 + g * 16 + 4 * kq) = w; }
}
__device__ __forceinline__ void s5s_item(ArgsRef A, int item, LAS unsigned char* lds, int lane, int wave) {
    unsigned char* ws = A.ws; const int pair = item * 8 + wave, b = pair >> 5, g = pair & 31, p = lane;
    const bf16_t* H1 = (const bf16_t*)(ws + WS_H1); const float* PW = (const float*)(ws + WS_POW); const float* BB = (const float*)(ws + WS_BB); bf16_t* G = (bf16_t*)(ws + WS_G);
    LAS float* sb = (LAS float*)(lds + wave * 9216);
    float sr = A.in[4][(size_t)(b * 32 + g) * 64 + p], si = A.in[5][(size_t)(b * 32 + g) * 64 + p];
    const float lr = PW[(size_t)((g * 65 + 1) * 64 + p) * 2], li = PW[(size_t)((g * 65 + 1) * 64 + p) * 2 + 1];
    f32x4 bq[8];
#pragma unroll
    for (int i = 0; i < 8; ++i) bq[i] = *(const f32x4*)(BB + (size_t)((g * 64 + p) * 16) * 2 + 4 * i);
    LAS unsigned* ub = (LAS unsigned*)(lds + 73728 + wave * 512);
    if (lane < 32) { const u32x4 uv = *(const u32x4*)(H1 + (size_t)(MPR + 16 * b + (lane >> 1)) * NIN + 640 + g * 16 + 8 * (lane & 1)); *(LAS u32x4*)(ub + lane * 4) = uv; }
    LDS_WAIT();
    for (int t = 0; t < 16; ++t) { const u32x4 u0 = *(const LAS u32x4*)(ub + t * 8), u1 = *(const LAS u32x4*)(ub + t * 8 + 4);
        float uu[16]; uu[0] = bflo(u0.x); uu[1] = bfhi(u0.x); uu[2] = bflo(u0.y); uu[3] = bfhi(u0.y); uu[4] = bflo(u0.z); uu[5] = bfhi(u0.z); uu[6] = bflo(u0.w); uu[7] = bfhi(u0.w);
        uu[8] = bflo(u1.x); uu[9] = bfhi(u1.x); uu[10] = bflo(u1.y); uu[11] = bfhi(u1.y); uu[12] = bflo(u1.z); uu[13] = bfhi(u1.z); uu[14] = bflo(u1.w); uu[15] = bfhi(u1.w);
        float br = 0.f, bi = 0.f;
#pragma unroll
        for (int i = 0; i < 8; ++i) { br += bq[i].x * uu[2 * i] + bq[i].z * uu[2 * i + 1]; bi += bq[i].y * uu[2 * i] + bq[i].w * uu[2 * i + 1]; }
        const float nr = lr * sr - li * si + br, ni = lr * si + li * sr + bi; sr = nr; si = ni; sb[t * 132 + p] = sr; sb[t * 132 + 64 + p] = si; }
    A.out[O_S5RS + (size_t)(b * 32 + g) * 64 + p] = sr; A.out[O_S5IS + (size_t)(b * 32 + g) * 64 + p] = si;
    LDS_WAIT();
    { const int l16 = lane & 15, kq = lane >> 4; f32x4 yacc = (f32x4){0.f, 0.f, 0.f, 0.f};
#pragma unroll
      for (int ks = 0; ks < 4; ++ks) { const int q0 = 32 * ks + 8 * kq; const bool im = q0 >= 64; const float* cp = (im ? A.in[21] : A.in[20]) + (size_t)(g * 16 + l16) * 64 + (q0 & 63);
          const f32x4 c0 = *(const f32x4*)cp, c1 = *(const f32x4*)(cp + 4); const float sg = im ? -1.f : 1.f;
          u32x4 aw; aw.x = pk2(sg * c0.x, sg * c0.y); aw.y = pk2(sg * c0.z, sg * c0.w); aw.z = pk2(sg * c1.x, sg * c1.y); aw.w = pk2(sg * c1.z, sg * c1.w);
          const f32x4 s0 = *(const LAS f32x4*)(sb + l16 * 132 + q0), s1 = *(const LAS f32x4*)(sb + l16 * 132 + q0 + 4);
          u32x4 bw; bw.x = pk2(s0.x, s0.y); bw.y = pk2(s0.z, s0.w); bw.z = pk2(s1.x, s1.y); bw.w = pk2(s1.z, s1.w);
          yacc = __builtin_amdgcn_mfma_f32_16x16x32_bf16(__builtin_bit_cast(bf16x8, aw), __builtin_bit_cast(bf16x8, bw), yacc, 0, 0, 0); }
      const int t = l16, c0i = 4 * kq; const size_t row = (size_t)(MPR + 16 * b + t); const u32x2 uw = *(const u32x2*)(H1 + row * NIN + 640 + g * 16 + c0i); const f32x4 dv = *(const f32x4*)(A.in[22] + g * 16 + c0i);
      const float y0 = yacc.x + dv.x * bflo(uw.x), y1 = yacc.y + dv.y * bfhi(uw.x), y2 = yacc.z + dv.z * bflo(uw.y), y3 = yacc.w + dv.w * bfhi(uw.y);
      u32x2 w; w.x = pk2(gelu_tanh(y0), gelu_tanh(y1)); w.y = pk2(gelu_tanh(y2), gelu_tanh(y3)); *(u32x2*)(G + row * 512 + g * 16 + c0i) = w; }
    LDS_WAIT();
}
template <int KSW, bool IS_OUT>
__device__ __forceinline__ void skinny_pair(ArgsRef A, int it0, LAS unsigned char* lds, int lane, int wave) {
    unsigned char* ws = A.ws; const int l16 = lane & 15, kq = lane >> 4; constexpr int K = IS_OUT ? 1024 : 2816;
    const bf16_t* Am = (const bf16_t*)(ws + (IS_OUT ? WS_MIX : WS_ACT)); const bf16_t* Bm = (const bf16_t*)(ws + (IS_OUT ? WS_WOUT : WS_WDN));
    const int myit = it0 + 256 * (wave & 1), mcg = myit & 63, mrg = myit >> 6, mcol = 16 * mcg + l16;
    float res[4] = {0.f, 0.f, 0.f, 0.f};
    if (wave < 2) {
#pragma unroll
        for (int i = 0; i < 4; ++i) { const int sr = 16 * mrg + 4 * kq + i; res[i] = IS_OUT ? A.in[1][(size_t)sr * 1024 + mcol] : A.out[(size_t)(MPR + sr) * 1024 + mcol]; } }
    f32x4 acc[2];
    if constexpr (KSW <= 4) {
        bf16x8 av[2][KSW], bv[2][KSW];
#pragma unroll
        for (int j = 0; j < 2; ++j) { const int it = it0 + 256 * j, cg_ = it & 63, rg = it >> 6;
            const bf16_t* ap = Am + (size_t)(MPR + 16 * rg + l16) * K + 8 * kq + wave * KSW * 32; const bf16_t* bp = Bm + (size_t)(16 * cg_ + l16) * K + 8 * kq + wave * KSW * 32;
#pragma unroll
            for (int ks = 0; ks < KSW; ++ks) { av[j][ks] = *(const bf16x8*)(ap + 32 * ks); bv[j][ks] = *(const bf16x8*)(bp + 32 * ks); } }
#pragma unroll
        for (int j = 0; j < 2; ++j) { acc[j] = (f32x4){0.f, 0.f, 0.f, 0.f};
#pragma unroll
            for (int ks = 0; ks < KSW; ++ks) acc[j] = __builtin_amdgcn_mfma_f32_16x16x32_bf16(av[j][ks], bv[j][ks], acc[j], 0, 0, 0); }
    } else {
#pragma unroll
        for (int j = 0; j < 2; ++j) { const int it = it0 + 256 * j, cg_ = it & 63, rg = it >> 6;
            const bf16_t* ap = Am + (size_t)(MPR + 16 * rg + l16) * K + 8 * kq + wave * KSW * 32; const bf16_t* bp = Bm + (size_t)(16 * cg_ + l16) * K + 8 * kq + wave * KSW * 32;
            bf16x8 av[KSW], bv[KSW];
#pragma unroll
            for (int ks = 0; ks < KSW; ++ks) { av[ks] = *(const bf16x8*)(ap + 32 * ks); bv[ks] = *(const bf16x8*)(bp + 32 * ks); }
            acc[j] = (f32x4){0.f, 0.f, 0.f, 0.f};
#pragma unroll
            for (int ks = 0; ks < KSW; ++ks) acc[j] = __builtin_amdgcn_mfma_f32_16x16x32_bf16(av[ks], bv[ks], acc[j], 0, 0, 0); }
    }
    LAS f32x4* red = (LAS f32x4*)lds;
    red[(0 * 8 + wave) * 64 + lane] = acc[0]; red[(1 * 8 + wave) * 64 + lane] = acc[1];
    __syncthreads();
    if (wave < 2) { f32x4 s = red[(wave * 8) * 64 + lane];
#pragma unroll
        for (int w = 1; w < 8; ++w) s += red[(wave * 8 + w) * 64 + lane];
#pragma unroll
        for (int i = 0; i < 4; ++i) { const int sr = 16 * mrg + 4 * kq + i; float* op = A.out + (size_t)(MPR + sr) * 1024 + mcol; const float h = res[i] + s[i]; *op = h;
            if (IS_OUT) { ((bf16_t*)(ws + WS_HB))[(size_t)(MPR + sr) * 1024 + mcol] = (bf16_t)(pk2(h, 0.f) & 0xffffu);
                float q = h * h; q += __shfl_xor(q, 1); q += __shfl_xor(q, 2); q += __shfl_xor(q, 4); q += __shfl_xor(q, 8); if (l16 == 0) ((float*)(ws + WS_SSS))[sr * 64 + mcg] = q; } } }
    __syncthreads();
}
__device__ __forceinline__ void p8_fixup(ArgsRef A, int tid) {
    unsigned char* ws = A.ws; const float* SIDE = (const float*)(ws + WS_SIDE); bf16_t* ACT = (bf16_t*)(ws + WS_ACT); const float* wdw = A.in[28]; const float* bdw = A.in[29];
    const int gt = blockIdx.x * 512 + tid, NGT = gridDim.x * 512;
    for (int i = gt; i < 60 * 2 * 2816; i += NGT) { const int j = i % 2816, rr = (i / 2816) & 1, t60 = i / 5632; const int pm = (t60 / 15) * 16 + (t60 % 15) + 1;
        const int pg = 256 * (j >> 7) + (j & 127), pv = pg + 128; const float* s0 = SIDE + (size_t)((pm - 1) * 4) * 5632; const float* s1 = SIDE + (size_t)(pm * 4) * 5632;
        float g2, g1, g0, v2, v1, v0;
        if (rr == 0) { g2 = s0[2 * 5632 + pg]; g1 = s0[3 * 5632 + pg]; g0 = s1[pg]; v2 = s0[2 * 5632 + pv]; v1 = s0[3 * 5632 + pv]; v0 = s1[pv]; }
        else { g2 = s0[3 * 5632 + pg]; g1 = s1[pg]; g0 = s1[5632 + pg]; v2 = s0[3 * 5632 + pv]; v1 = s1[pv]; v0 = s1[5632 + pv]; }
        const float cg = wdw[j] * g2 + wdw[5632 + j] * g1 + wdw[2 * 5632 + j] * g0 + bdw[j];
        const float cv = wdw[2816 + j] * v2 + wdw[5632 + 2816 + j] * v1 + wdw[2 * 5632 + 2816 + j] * v0 + bdw[2816 + j];
        ACT[(size_t)(pm * 256 + rr) * 2816 + j] = (bf16_t)(pk2(cg * sigmoidf_(cg) * cv, 0.f) & 0xffffu); }
}
#define XB_TMO      128
#define XB_XCNT(j)  (256  + 64 * (j))
#define XB_XSUB(j)  (1280 + 64 * (j))
#define XB_XGEN(j)  (2304 + 64 * (j))
#define XB_TOP      3328
#define XB_TOPGEN   3392
#define XCD_BAR_WORDS 3456
#define XB_SPIN_CAP (1u << 18)

__device__ __forceinline__ unsigned xb_ld(unsigned* p)              { return __hip_atomic_load(p, __ATOMIC_RELAXED, __HIP_MEMORY_SCOPE_AGENT); }
__device__ __forceinline__ unsigned xb_add(unsigned* p, unsigned v) { return __hip_atomic_fetch_add(p, v, __ATOMIC_RELAXED, __HIP_MEMORY_SCOPE_AGENT); }
__device__ __forceinline__ unsigned xb_xcc_id() { return (unsigned)__builtin_amdgcn_s_getreg((3 << 11) | 20) & 0xFu; }
#define XB_SPIN(cond, bar) do { unsigned _sp = 0; while (cond) { __builtin_amdgcn_s_sleep(1); \
    if ((++_sp & 255u) == 0u) { if (xb_ld(&(bar)[XB_TMO])) break; if (_sp > XB_SPIN_CAP) { atomicAdd(&(bar)[XB_TMO], 1u); break; } } } } while (0)

struct XcdBarrier {
    unsigned* bar; unsigned x;
    volatile LAS unsigned* st;
};

__device__ __forceinline__ XcdBarrier xcd_barrier_post(unsigned* bar, volatile LAS unsigned* st) {
    XcdBarrier b; b.bar = bar; b.x = xb_xcc_id(); b.st = st;
    if (threadIdx.x == 0) (void)xb_add(&bar[XB_XCNT(b.x)], 1u);
    return b;
}
__device__ __forceinline__ void xcd_barrier_complete(unsigned* bar, unsigned x, unsigned& nloc, unsigned& nx) {
    const unsigned G = gridDim.x * gridDim.y * gridDim.z;
    unsigned sum, cnt, mine, sp = 0u;
    for (;;) {
        sum = 0u; cnt = 0u; mine = 0u;
#pragma unroll
        for (unsigned j = 0; j < 16; ++j) { const unsigned c = xb_ld(&bar[XB_XCNT(j)]); sum += c; cnt += (c > 0u) ? 1u : 0u; mine = (j == x) ? c : mine; }
        if (sum == G) break;
        __builtin_amdgcn_s_sleep(1);
        if ((++sp & 255u) == 0u) { if (xb_ld(&bar[XB_TMO])) break; if (sp > XB_SPIN_CAP) { atomicAdd(&bar[XB_TMO], 1u); break; } }
    }
    nloc = mine > 0u ? mine : 1u; nx = cnt > 0u ? cnt : 1u;
}

__device__ __forceinline__ void xcd_barrier(const XcdBarrier& b) {
    asm volatile("s_waitcnt vmcnt(0)" ::: "memory");
    __syncthreads();
    if (threadIdx.x == 0) {
        unsigned* bar = b.bar;
        __builtin_amdgcn_s_waitcnt(0);
        unsigned nloc = b.st[0], nx = b.st[1];
        if (nloc == 0u) { xcd_barrier_complete(bar, b.x, nloc, nx); b.st[0] = nloc; b.st[1] = nx; }
        const unsigned old = xb_add(&bar[XB_XSUB(b.x)], 1u);
        const unsigned gen = old / nloc;
        if (old + 1u == (gen + 1u) * nloc) {
            __builtin_amdgcn_fence(__ATOMIC_RELEASE, "agent");
            asm volatile("s_waitcnt vmcnt(0)" ::: "memory");
            const unsigned og = xb_add(&bar[XB_TOP], 1u);
            const unsigned tg = og / nx;
            if (og + 1u == (tg + 1u) * nx) xb_add(&bar[XB_TOPGEN], 1u);
            else XB_SPIN(xb_ld(&bar[XB_TOPGEN]) == tg, bar);
            __builtin_amdgcn_fence(__ATOMIC_ACQUIRE, "agent");
            xb_add(&bar[XB_XGEN(b.x)], 1u);
            asm volatile("s_waitcnt vmcnt(0)" ::: "memory");
        } else {
            XB_SPIN(xb_ld(&bar[XB_XGEN(b.x)]) == gen, bar);
            __builtin_amdgcn_fence(__ATOMIC_ACQUIRE, "agent");
            asm volatile("s_waitcnt vmcnt(0)" ::: "memory");
        }
    }
    __syncthreads();
}

#ifndef DUPMASK
#define DUPMASK 0
#endif
#ifndef PROBE_AV
#define PROBE_AV 0
#endif
#define REP(k) for (int rep_ = 0; rep_ < (((DUPMASK) >> (k)) & 1 ? 2 : 1); ++rep_)
__device__ __forceinline__ CArgs* args_opaque(CArgs* p) { asm volatile("" : "+s"(p)); return p; }
__global__ void __launch_bounds__(512, 2) fwd_kernel(Args A0) {
#define A (*args_opaque((CArgs*)__builtin_amdgcn_kernarg_segment_ptr()))
    extern __shared__ __attribute__((aligned(16))) unsigned char lds_raw[];
    LAS unsigned char* lds = (LAS unsigned char*)lds_raw;
    cg::grid_group grid = cg::this_grid();
    if (threadIdx.x < 16) ((LAS unsigned*)(lds + LDS_QW))[threadIdx.x] = 0u;
    __syncthreads();
    XcdBarrier bar = xcd_barrier_post((unsigned*)(A.ws + WS_CTL) + 4096, (volatile LAS unsigned*)(lds + LDS_QW + 32));
    if (A.ws == nullptr) grid.sync();
#define GSYNC() xcd_barrier(bar)
    const int wave_s = __builtin_amdgcn_readfirstlane((int)threadIdx.x >> 6);
#define PHASE_IDS() const int wave = wave_s; int tid = lane_id_asm() + 64 * wave_s; asm volatile("" : "+v"(tid)); const int lane = tid & 63; (void)lane; (void)wave
    unsigned char* ws = A.ws; const int G = gridDim.x, bx = blockIdx.x;
#ifdef EXTRA_SYNCS
    for (int es_ = 0; es_ < EXTRA_SYNCS; ++es_) GSYNC();
#endif
    REP(0) { { PHASE_IDS(); p0_prologue(A, lds, tid, lane, wave); }
    GSYNC(); }
    REP(1) {if (bx >= 69) { PHASE_IDS(); p1_tables(A, tid, 69); __syncthreads(); idle_transposes(A, lds, lane, wave, 69, 0); __syncthreads(); }
    { pg8::Gemm g{(const bf16_t*)(ws + WS_XN), (const bf16_t*)(ws + WS_WIN), MP, NIN, 1024}; pg8::StaticOrder S; S.init(MP, NIN, G, bx); S.wave_s = wave_s;
      pg8::EpiBf16<0> E{(bf16_t*)(ws + WS_H1), NIN, nullptr, 0, 0, 1.f};
      pg8::gemm_phase<pg8::EpiBf16<0>, pg8::StaticOrder, true, true>(lds, g, S, E); }
    GSYNC(); }
    REP(2) { { PHASE_IDS(); p2_rows(A, lane, wave); }
    { PHASE_IDS(); p2_s5loc(A, lane, wave); }
    GSYNC(); }
    REP(3) {{ pg8::Gemm g{(const bf16_t*)(ws + WS_CKV), (const bf16_t*)(ws + WS_WKV), MKV, 1024, 256}; pg8::StaticOrder S; S.init(MKV, 1024, G, bx); S.wave_s = wave_s;
      EpiKV E{A};
      pg8::gemm_phase<EpiKV, pg8::StaticOrder, true, true>(lds, g, S, E); }
    { pg8::Gemm g{(const bf16_t*)(ws + WS_CQ), (const bf16_t*)(ws + WS_WQ), MP, 768, 384}; pg8::StaticOrder S; S.init(MP, 768, G, G - 1 - bx);     S.wave_s = wave_s;
      pg8::EpiBf16<0> E{(bf16_t*)(ws + WS_QRAW), 768, nullptr, 0, 0, 1.f};
      pg8::gemm_phase<pg8::EpiBf16<0>, pg8::StaticOrder, true, true>(lds, g, S, E); }
    GSYNC(); }
    REP(4) { { PHASE_IDS(); unsigned* ctr = (unsigned*)(ws + WS_CTL) + 512 * rep_; LAS int* qw = (LAS int*)(lds + LDS_QW); const int xcc = (int)(xb_xcc_id() & 7u);
#define Q_POP(dst) do { dst = -1; for (int k_ = 0; k_ < 8; ++k_) { const int qq_ = (xcc + k_) & 7; const unsigned v_ = atomicAdd(ctr + 64 * qq_, 1u); if (v_ < 108u) { dst = qq_ * 128 + (int)v_; break; } } } while (0)
      int nextcode = -1;
      if (tid == 0) { Q_POP(nextcode); *qw = nextcode; }
      for (;;) {
          __syncthreads();
          const int code = __builtin_amdgcn_readfirstlane(*qw);
          __syncthreads();
          if (code < 0) break;
          unsigned vown = 0xffffffffu; if (tid == 0) vown = atomicAdd(ctr + 64 * xcc, 1u);
          const int x = code >> 7, li = code & 127;
          int tid2 = tid; asm volatile("" : "+v"(tid2)); const int lane2 = tid2 & 63;
          const bool skip_s5 = ((DUPMASK) & 0x400) && rep_ == 1, skip_at = ((DUPMASK) & 0x800) && rep_ == 1;
          if (li < 32) { if (!skip_at) attn_unit((PROBE_AV != 0 && rep_ == 1) ? PROBE_AV : 0, A, false, x >> 1, 4 * (x & 1) + (li & 3), 15 - (li >> 2), lds, tid2, lane2, wave); }
          else if (li < 40) { if (!skip_at) attn_unit((PROBE_AV != 0 && rep_ == 1) ? PROBE_AV : 0, A, true, x, li - 32, 0, lds, tid2, lane2, wave); }
          else if (li < 44) { if (!skip_s5 && !(((DUPMASK) & 0x2000) && rep_ == 1)) s5s_item(A, 4 * x + (li - 40), lds, lane2, wave); }
          else { const int k = li - 44; if (k & 1) { if (!skip_s5) s5y_item(A, 32 * x + (k >> 1), lds, tid2, lane2, wave); } else if (!skip_at) attn_unit((PROBE_AV != 0 && rep_ == 1) ? PROBE_AV : 0, A, false, x >> 1, 4 * (x & 1) + ((k >> 1) & 3), 7 - (k >> 3), lds, tid2, lane2, wave); }
          if (tid == 0) { if (vown < 108u) nextcode = xcc * 128 + (int)vown; else Q_POP(nextcode); *qw = nextcode; }
      } }
#undef Q_POP
    GSYNC(); }
    REP(5) { if (bx >= 130) { PHASE_IDS(); idle_transposes(A, lds, lane, wave, 130, 1); }
    { pg8::Gemm g{(const bf16_t*)(ws + WS_G), (const bf16_t*)(ws + WS_WGLU), MP, 512, 512}; pg8::StaticOrder S; S.init(MP, 512, G, bx); S.wave_s = wave_s;
      EpiGLU E{A};
      pg8::gemm_phase<EpiGLU, pg8::StaticOrder, true, true>(lds, g, S, E); }
    GSYNC(); }
    REP(6) {{ pg8::Gemm g{(const bf16_t*)(ws + WS_MIX), (const bf16_t*)(ws + WS_WOUT), MPR, 1024, 1024}; pg8::StaticOrder S; S.init(MPR, 1024, G, bx); S.wave_s = wave_s;
      EpiOut E{A};
      pg8::gemm_phase<EpiOut, pg8::StaticOrder, true, true>(lds, g, S, E); }
    if (!(((DUPMASK) & 0x1000) && rep_ == 1)) { PHASE_IDS(); if (bx < 256) skinny_pair<4, true>(A, bx, lds, lane, wave); }
    GSYNC(); }
    REP(7) {{ pg8::Gemm g{(const bf16_t*)(ws + WS_HB), (const bf16_t*)(ws + WS_WUP), MP, 5632, 1024}; pg8::StaticOrder S; S.init(MP, 5632, G, bx); S.wave_s = wave_s;
      EpiUp E{A, (LAS float*)(lds + LDS_XCH)};
      pg8::gemm_phase<EpiUp, pg8::StaticOrder, true, true>(lds, g, S, E); }
    GSYNC(); }
    { PHASE_IDS(); p8_fixup(A, tid); }
    GSYNC();
    if ((DUPMASK) & 0x200) { pg8::Gemm g{(const bf16_t*)(ws + WS_ACT), (const bf16_t*)(ws + WS_WDN), MPR, 1024, 2816}; pg8::StaticOrder S; S.init(MPR, 1024, G, bx); S.wave_s = wave_s;
      EpiNull E{A}; pg8::gemm_phase<EpiNull, pg8::StaticOrder, true, true>(lds, g, S, E); GSYNC(); }
    { pg8::Gemm g{(const bf16_t*)(ws + WS_ACT), (const bf16_t*)(ws + WS_WDN), MPR, 1024, 2816}; pg8::StaticOrder S; S.init(MPR, 1024, G, bx); S.wave_s = wave_s;
      EpiDown E{A};
      pg8::gemm_phase<EpiDown, pg8::StaticOrder, true, true>(lds, g, S, E); }
    { PHASE_IDS(); if (bx < 256) skinny_pair<11, false>(A, bx, lds, lane, wave); }
}

#undef A
extern "C" void kernel_launch(void* const* d_in, const int* in_sizes, int n_in, void* d_out, int out_size, void* d_ws, size_t ws_size, hipStream_t stream) {
    static int grid = 0;
    if (grid == 0) {
        if (n_in != 31 || ws_size < WS_END) { fprintf(stderr, "kernel_launch: unexpected n_in %d / ws %zu\n", n_in, ws_size); grid = -1; return; }
        int dev = 0, cus = 0, per_cu = 0;
        hipGetDevice(&dev); hipDeviceGetAttribute(&cus, hipDeviceAttributeMultiprocessorCount, dev);
        hipFuncSetAttribute((const void*)fwd_kernel, hipFuncAttributeMaxDynamicSharedMemorySize, LDS_TOTAL);
        hipOccupancyMaxActiveBlocksPerMultiprocessor(&per_cu, (const void*)fwd_kernel, 512, LDS_TOTAL);
        (void)hipGetLastError();
        grid = cus > 0 ? cus : 256;
        if (per_cu < 1) fprintf(stderr, "kernel_launch: occupancy query says %d blocks/CU\n", per_cu);
    }
    if (grid < 0) return;
    if (hipMemsetAsync((char*)d_ws + WS_CTL, 0, 32768, stream) != hipSuccess) { fprintf(stderr, "kernel_launch: memset failed\n"); return; }
    Args a{};
    for (int i = 0; i < 31; ++i) a.in[i] = (const float*)d_in[i];
    a.out = (float*)d_out; a.ws = (unsigned char*)d_ws;
    void* args[] = {&a};
    hipError_t e = hipLaunchCooperativeKernel((const void*)fwd_kernel, dim3(grid), dim3(512), args, LDS_TOTAL, stream);
    if (e != hipSuccess) fprintf(stderr, "cooperative launch failed: %s (grid %d)\n", hipGetErrorString(e), grid);
}
```
